# Optimizing an MI355X kernel written in HIP

```python
import math
import jax, jax.numpy as jnp
from jax import lax
import numpy as np

D_MODEL = 1024
BATCH = 4
SEQ = 4096
DEPTH = 2

N_EVEN = (DEPTH + 1) // 2
N_ODD = DEPTH // 2
NORM_EPS = 1e-6

SSM_WIDTH = 512
SSM_GROUP = 16
SSM_GROUPS = SSM_WIDTH // SSM_GROUP
SSM_STATE = 64
DT_MIN = 1e-3
DT_MAX = 1e-1
SGU_WIDTH = 512
SGU_HEADS = 8
SGU_HEAD_DIM = SGU_WIDTH // SGU_HEADS
SGU_CHUNK = 128
EVEN_IN = SSM_WIDTH + 2 * SGU_WIDTH
EVEN_MIX = SSM_WIDTH + SGU_WIDTH
CONV_CH = 512
CONV_TAPS = 31
MLA_HEADS = 8
MLA_Q_RANK = 256
MLA_KV_RANK = 128
MLA_NOPE = 64
MLA_ROPE = 32
MLA_V = 64
ROPE_THETA = 10000.0
ATTN_BLOCK = 128
ODD_IN = 2 * CONV_CH + MLA_Q_RANK + MLA_KV_RANK + MLA_ROPE
ODD_MIX = CONV_CH + MLA_HEADS * MLA_V
FF_DENSE = 4096
N_EXPERTS = 8
TOP_K = 2
FF_EXPERT = 3584

kernel_name = 'hybrid_s5_sgu_conformer_mla_moe'


def rms_norm(x, g):
    x32 = x.astype(jnp.float32)
    y = x32 * lax.rsqrt(jnp.mean(x32 * x32, axis=-1, keepdims=True) + NORM_EPS)
    return (y * g.astype(jnp.float32)).astype(x.dtype)


def layer_norm(x, g, b):
    x32 = x.astype(jnp.float32)
    mu = jnp.mean(x32, axis=-1, keepdims=True)
    xc = x32 - mu
    y = xc * lax.rsqrt(jnp.mean(xc * xc, axis=-1, keepdims=True) + NORM_EPS)
    return (y * g.astype(jnp.float32) + b.astype(jnp.float32)).astype(x.dtype)


def swiglu(x, w_gate, w_up, w_down):
    return (jax.nn.silu(x @ w_gate) * (x @ w_up)) @ w_down


def s5_mixer(u, lam_re, lam_im, log_dt, b_re, b_im, c_re, c_im, d, w_glu):
    f32 = jnp.float32
    bsz, seq, _ = u.shape
    u32 = u.astype(f32)
    ug = u32.reshape(bsz, seq, SSM_GROUPS, SSM_GROUP)
    lr = jnp.minimum(lam_re.astype(f32), -1e-4)
    li = lam_im.astype(f32)
    dt = jnp.exp(log_dt.astype(f32))[:, None]
    mag = jnp.exp(lr * dt)
    lb_re = mag * jnp.cos(li * dt)
    lb_im = mag * jnp.sin(li * dt)
    den = lr * lr + li * li
    nr = lb_re - 1.0
    coef_re = (nr * lr + lb_im * li) / den
    coef_im = (lb_im * lr - nr * li) / den
    br = b_re.astype(f32)
    bi = b_im.astype(f32)
    bb_re = coef_re[..., None] * br - coef_im[..., None] * bi
    bb_im = coef_re[..., None] * bi + coef_im[..., None] * br
    bu_re = jnp.einsum('gpn,blgn->blgp', bb_re, ug)
    bu_im = jnp.einsum('gpn,blgn->blgp', bb_im, ug)
    a_re = jnp.broadcast_to(lb_re, bu_re.shape)
    a_im = jnp.broadcast_to(lb_im, bu_im.shape)

    def combine(e1, e2):
        a1r, a1i, b1r, b1i = e1
        a2r, a2i, b2r, b2i = e2
        return (a2r * a1r - a2i * a1i,
                a2r * a1i + a2i * a1r,
                a2r * b1r - a2i * b1i + b2r,
                a2r * b1i + a2i * b1r + b2i)

    _, _, h_re, h_im = lax.associative_scan(combine, (a_re, a_im, bu_re, bu_im), axis=1)
    y = (jnp.einsum('gnp,blgp->blgn', c_re.astype(f32), h_re)
         - jnp.einsum('gnp,blgp->blgn', c_im.astype(f32), h_im))
    y = y.reshape(bsz, seq, SSM_WIDTH) + d.astype(f32) * u32
    y = jax.nn.gelu(y).astype(u.dtype)
    return y * jax.nn.sigmoid(y @ w_glu)


def sgu_mixer(u, v, ln_g, ln_b, w_s, b_s):
    bsz, seq, _ = u.shape
    u = jax.nn.gelu(u)
    v = layer_norm(jax.nn.gelu(v), ln_g, ln_b)
    n_chunks = seq // SGU_CHUNK
    v = v.reshape(bsz, n_chunks, SGU_CHUNK, SGU_HEADS, SGU_HEAD_DIM)
    causal = jnp.tril(jnp.ones((SGU_CHUNK, SGU_CHUNK), dtype=bool))
    w = jnp.where(causal[None], w_s, jnp.zeros((), w_s.dtype))
    s = jnp.einsum('hts,bcshd->bcthd', w, v) + b_s.T[None, None, :, :, None]
    return u * s.reshape(bsz, seq, SGU_WIDTH)


def conv_mixer(z, w, b, ln_g, ln_b):
    a, g = jnp.split(z, 2, axis=-1)
    h = a * jax.nn.sigmoid(g)
    h = lax.conv_general_dilated(h, w[:, None, :], window_strides=(1,),
                                 padding=[(CONV_TAPS - 1, 0)],
                                 dimension_numbers=('NWC', 'WIO', 'NWC'),
                                 feature_group_count=CONV_CH) + b
    h = layer_norm(h, ln_g, ln_b)
    return jax.nn.silu(h)


def rope_tables(seq):
    inv = 1.0 / (ROPE_THETA ** (jnp.arange(0, MLA_ROPE, 2, dtype=jnp.float32) / MLA_ROPE))
    ang = jnp.arange(seq, dtype=jnp.float32)[:, None] * inv[None, :]
    return jnp.cos(ang), jnp.sin(ang)


def apply_rope(x, cos, sin):
    half = x.shape[-1] // 2
    x32 = x.astype(jnp.float32)
    x1 = x32[..., :half]
    x2 = x32[..., half:]
    return jnp.concatenate([x1 * cos - x2 * sin, x2 * cos + x1 * sin], axis=-1).astype(x.dtype)


def mla_mixer(c_q, c_kv, k_rope, q_norm_g, w_uq, kv_norm_g, w_ukv, cos, sin):
    bsz, seq, _ = c_q.shape
    dk = MLA_NOPE + MLA_ROPE
    q = (rms_norm(c_q, q_norm_g) @ w_uq).reshape(bsz, seq, MLA_HEADS, dk)
    q_rope = apply_rope(q[..., MLA_NOPE:], cos[None, :, None, :], sin[None, :, None, :])
    q = jnp.concatenate([q[..., :MLA_NOPE], q_rope], axis=-1)
    kv = (rms_norm(c_kv, kv_norm_g) @ w_ukv).reshape(bsz, seq, MLA_HEADS, MLA_NOPE + MLA_V)
    k_r = apply_rope(k_rope, cos[None], sin[None])
    k = jnp.concatenate([kv[..., :MLA_NOPE],
                         jnp.broadcast_to(k_r[:, :, None, :], (bsz, seq, MLA_HEADS, MLA_ROPE))], axis=-1)
    kh = k.transpose(0, 2, 1, 3)
    vh = kv[..., MLA_NOPE:].transpose(0, 2, 1, 3)
    n_blocks = seq // ATTN_BLOCK
    qb = q.reshape(bsz, n_blocks, ATTN_BLOCK, MLA_HEADS, dk).transpose(1, 0, 3, 2, 4)
    scale = dk ** -0.5
    k_pos = jnp.arange(seq)

    def attend(args):
        q_blk, blk = args
        s = jnp.einsum('bhqd,bhkd->bhqk', q_blk, kh).astype(jnp.float32) * scale
        q_pos = blk * ATTN_BLOCK + jnp.arange(ATTN_BLOCK)
        s = jnp.where(k_pos[None, :] <= q_pos[:, None], s, -1e30)
        p = jax.nn.softmax(s, axis=-1).astype(vh.dtype)
        return jnp.einsum('bhqk,bhkd->bhqd', p, vh)

    o = lax.map(attend, (qb, jnp.arange(n_blocks)))
    return o.transpose(1, 0, 3, 2, 4).reshape(bsz, seq, MLA_HEADS * MLA_V)


def moe_ffn(x, w_router, w_gate, w_up, w_down):
    bsz, seq, d = x.shape
    xt = x.reshape(-1, d)
    logits = (xt @ w_router).astype(jnp.float32)
    top_val, top_idx = lax.top_k(logits, TOP_K)
    top_w = jax.nn.softmax(top_val, axis=-1)
    gates = jnp.sum(jax.nn.one_hot(top_idx, N_EXPERTS, dtype=jnp.float32) * top_w[..., None], axis=1)
    out = jnp.zeros_like(xt)
    for e in range(N_EXPERTS):
        out = out + gates[:, e:e + 1].astype(x.dtype) * swiglu(xt, w_gate[e], w_up[e], w_down[e])
    return out.reshape(bsz, seq, d)


def setup_inputs(seed: int = 0) -> dict:
    key = jax.random.key(seed)
    ks = iter(jax.random.split(key, 48))

    def nrm(shape, scale):
        return scale * jax.random.normal(next(ks), shape, jnp.float32)

    def gain(shape):
        return 1.0 + nrm(shape, 0.05)

    x = nrm((BATCH, SEQ, D_MODEL), 1.0)
    norm_g = gain((DEPTH, 4, D_MODEL))
    ev_w_in = nrm((N_EVEN, D_MODEL, EVEN_IN), D_MODEL ** -0.5)
    ssm_lambda_re = -0.5 + nrm((N_EVEN, SSM_GROUPS, SSM_STATE), 0.01)
    ssm_lambda_im = jnp.pi * jnp.arange(SSM_STATE, dtype=jnp.float32) + nrm((N_EVEN, SSM_GROUPS, SSM_STATE), 0.01)
    ssm_log_dt = jax.random.uniform(next(ks), (N_EVEN, SSM_GROUPS), jnp.float32, math.log(DT_MIN), math.log(DT_MAX))
    ssm_b_re = nrm((N_EVEN, SSM_GROUPS, SSM_STATE, SSM_GROUP), (2 * SSM_GROUP) ** -0.5)
    ssm_b_im = nrm((N_EVEN, SSM_GROUPS, SSM_STATE, SSM_GROUP), (2 * SSM_GROUP) ** -0.5)
    ssm_c_re = nrm((N_EVEN, SSM_GROUPS, SSM_GROUP, SSM_STATE), SSM_STATE ** -0.5)
    ssm_c_im = nrm((N_EVEN, SSM_GROUPS, SSM_GROUP, SSM_STATE), SSM_STATE ** -0.5)
    ssm_d = nrm((N_EVEN, SSM_WIDTH), 0.1)
    ssm_w_glu = nrm((N_EVEN, SSM_WIDTH, SSM_WIDTH), SSM_WIDTH ** -0.5)
    sgu_ln_g = gain((N_EVEN, SGU_WIDTH))
    sgu_ln_b = nrm((N_EVEN, SGU_WIDTH), 0.02)
    sgu_w = nrm((N_EVEN, SGU_HEADS, SGU_CHUNK, SGU_CHUNK), 0.5 * SGU_CHUNK ** -0.5)
    sgu_b = gain((N_EVEN, SGU_HEADS, SGU_CHUNK))
    ev_w_out = nrm((N_EVEN, EVEN_MIX, D_MODEL), EVEN_MIX ** -0.5)
    ffn_w_gate = nrm((N_EVEN, D_MODEL, FF_DENSE), D_MODEL ** -0.5)
    ffn_w_up = nrm((N_EVEN, D_MODEL, FF_DENSE), D_MODEL ** -0.5)
    ffn_w_down = nrm((N_EVEN, FF_DENSE, D_MODEL), FF_DENSE ** -0.5)
    od_w_in = nrm((N_ODD, D_MODEL, ODD_IN), D_MODEL ** -0.5)
    conv_w = nrm((N_ODD, CONV_TAPS, CONV_CH), CONV_TAPS ** -0.5)
    conv_b = nrm((N_ODD, CONV_CH), 0.02)
    conv_ln_g = gain((N_ODD, CONV_CH))
    conv_ln_b = nrm((N_ODD, CONV_CH), 0.02)
    mla_q_norm_g = gain((N_ODD, MLA_Q_RANK))
    mla_w_uq = nrm((N_ODD, MLA_Q_RANK, MLA_HEADS * (MLA_NOPE + MLA_ROPE)), MLA_Q_RANK ** -0.5)
    mla_kv_norm_g = gain((N_ODD, MLA_KV_RANK))
    mla_w_ukv = nrm((N_ODD, MLA_KV_RANK, MLA_HEADS * (MLA_NOPE + MLA_V)), MLA_KV_RANK ** -0.5)
    od_w_out = nrm((N_ODD, ODD_MIX, D_MODEL), ODD_MIX ** -0.5)
    moe_w_router = nrm((N_ODD, D_MODEL, N_EXPERTS), D_MODEL ** -0.5)
    moe_w_gate = nrm((N_ODD, N_EXPERTS, D_MODEL, FF_EXPERT), D_MODEL ** -0.5)
    moe_w_up = nrm((N_ODD, N_EXPERTS, D_MODEL, FF_EXPERT), D_MODEL ** -0.5)
    moe_w_down = nrm((N_ODD, N_EXPERTS, FF_EXPERT, D_MODEL), FF_EXPERT ** -0.5)
    return {
        'x': x, 'norm_g': norm_g, 'ev_w_in': ev_w_in,
        'ssm_lambda_re': ssm_lambda_re, 'ssm_lambda_im': ssm_lambda_im, 'ssm_log_dt': ssm_log_dt,
        'ssm_b_re': ssm_b_re, 'ssm_b_im': ssm_b_im, 'ssm_c_re': ssm_c_re, 'ssm_c_im': ssm_c_im,
        'ssm_d': ssm_d, 'ssm_w_glu': ssm_w_glu,
        'sgu_ln_g': sgu_ln_g, 'sgu_ln_b': sgu_ln_b, 'sgu_w': sgu_w, 'sgu_b': sgu_b,
        'ev_w_out': ev_w_out, 'ffn_w_gate': ffn_w_gate, 'ffn_w_up': ffn_w_up, 'ffn_w_down': ffn_w_down,
        'od_w_in': od_w_in, 'conv_w': conv_w, 'conv_b': conv_b, 'conv_ln_g': conv_ln_g, 'conv_ln_b': conv_ln_b,
        'mla_q_norm_g': mla_q_norm_g, 'mla_w_uq': mla_w_uq, 'mla_kv_norm_g': mla_kv_norm_g, 'mla_w_ukv': mla_w_ukv,
        'od_w_out': od_w_out, 'moe_w_router': moe_w_router,
        'moe_w_gate': moe_w_gate, 'moe_w_up': moe_w_up, 'moe_w_down': moe_w_down,
    }


def reference(x, norm_g, ev_w_in, ssm_lambda_re, ssm_lambda_im, ssm_log_dt, ssm_b_re, ssm_b_im,
              ssm_c_re, ssm_c_im, ssm_d, ssm_w_glu, sgu_ln_g, sgu_ln_b, sgu_w, sgu_b, ev_w_out,
              ffn_w_gate, ffn_w_up, ffn_w_down, od_w_in, conv_w, conv_b, conv_ln_g, conv_ln_b,
              mla_q_norm_g, mla_w_uq, mla_kv_norm_g, mla_w_ukv, od_w_out, moe_w_router,
              moe_w_gate, moe_w_up, moe_w_down):
    seq = x.shape[1]
    cos, sin = rope_tables(seq)
    h = x
    for layer in range(DEPTH):
        i = layer // 2
        g = norm_g[layer]
        z = rms_norm(h, g[0])
        if layer % 2 == 0:
            proj = z @ ev_w_in[i]
            a_in = proj[..., :SSM_WIDTH]
            b_u = proj[..., SSM_WIDTH:SSM_WIDTH + SGU_WIDTH]
            b_v = proj[..., SSM_WIDTH + SGU_WIDTH:]
            y_a = s5_mixer(a_in, ssm_lambda_re[i], ssm_lambda_im[i], ssm_log_dt[i], ssm_b_re[i], ssm_b_im[i],
                           ssm_c_re[i], ssm_c_im[i], ssm_d[i], ssm_w_glu[i])
            y_b = sgu_mixer(b_u, b_v, sgu_ln_g[i], sgu_ln_b[i], sgu_w[i], sgu_b[i])
            mix = jnp.concatenate([y_a, y_b], axis=-1) @ ev_w_out[i]
        else:
            proj = z @ od_w_in[i]
            o1 = 2 * CONV_CH
            o2 = o1 + MLA_Q_RANK
            o3 = o2 + MLA_KV_RANK
            y_c = conv_mixer(proj[..., :o1], conv_w[i], conv_b[i], conv_ln_g[i], conv_ln_b[i])
            y_d = mla_mixer(proj[..., o1:o2], proj[..., o2:o3], proj[..., o3:], mla_q_norm_g[i], mla_w_uq[i],
                            mla_kv_norm_g[i], mla_w_ukv[i], cos, sin)
            mix = jnp.concatenate([y_c, y_d], axis=-1) @ od_w_out[i]
        h = h + rms_norm(mix, g[1])
        z = rms_norm(h, g[2])
        if layer % 2 == 0:
            f = swiglu(z, ffn_w_gate[i], ffn_w_up[i], ffn_w_down[i])
        else:
            f = moe_ffn(z, moe_w_router[i], moe_w_gate[i], moe_w_up[i], moe_w_down[i])
        h = h + rms_norm(f, g[3])
    return h
```

```cpp
#include <hip/hip_runtime.h>
#include <cstdio>
#include <cstdint>
namespace pg8 {
#define PG8_LAS __attribute__((address_space(3)))
typedef unsigned short bf16_t;
typedef short bf16x8 __attribute__((ext_vector_type(8)));
typedef float f32x4 __attribute__((ext_vector_type(4)));
typedef unsigned u32x4 __attribute__((ext_vector_type(4)));
constexpr int BM = 256, BK = 64, HALF = 128, HTB = HALF * BK * 2  , STAGE_BYTES = 8 * HTB, NXCD = 8, WGM = 8;

__host__ __device__ __forceinline__ int lds_byte(int r, int c) { const int st = (r >> 4) * 2 + (c >> 5), rr = r & 15, cc = c & 31, ob = rr * 64 + cc * 2; return st * 1024 + (ob ^ (((ob >> 9) & 1) << 5)); }
__host__ __device__ __forceinline__ void stage_rc(int b, int& R, int& C) { const int st = b / 1024, sb = b % 1024, swz = sb ^ (((sb >> 9) & 1) << 5); R = (st >> 1) * 16 + swz / 64; C = (st & 1) * 32 + (swz % 64) / 2; }
__host__ __device__ __forceinline__ int perm32(int rho) { const int n = rho >> 4, i = rho & 15; return 8 * (i >> 2) + 4 * n + (i & 3); }

struct Unit { int pm, pn; };
typedef int v4i_t __attribute__((ext_vector_type(4))); typedef int v8i_t __attribute__((ext_vector_type(8)));
struct Gemm { const bf16_t* A; const bf16_t* Bt; int M, N, K; int sa, sb; };

struct StaticOrder {
    int nM, nN, nwg, G, c;
    __host__ __device__ void init(int M, int N, int G_, int c_) { nM = M / BM; nN = N / BM; nwg = nM * nN; G = G_; c = c_; }
    __host__ __device__ bool next(int i, Unit& u) const {
        const long L = (long)i * G + c; if (L >= nwg) return false;
        int wgid = (int)L; { const int q = nwg / NXCD, r = nwg % NXCD, xcd = wgid % NXCD, off = wgid / NXCD; wgid = (xcd < r ? xcd * (q + 1) : r * (q + 1) + (xcd - r) * q) + off; }
        const int nig = WGM * nN, gid = wgid / nig, fm = gid * WGM, gsz = (nM - fm) < WGM ? (nM - fm) : WGM;
        u.pm = fm + ((wgid % nig) % gsz); u.pn = (wgid % nig) / gsz; return true;
    }
    __device__ __forceinline__ void a_ready(const Unit&) const {}
    __device__ __forceinline__ void done(const Unit&) const {}
};


typedef unsigned u32x2 __attribute__((ext_vector_type(2)));
__device__ __forceinline__ unsigned cvt_pk_bf16(float lo, float hi) { unsigned r; asm volatile("v_cvt_pk_bf16_f32 %0, %1, %2" : "=v"(r) : "v"(lo), "v"(hi)); return r; }
__device__ __forceinline__ float bf_lo(unsigned u) { return __uint_as_float(u << 16); }
__device__ __forceinline__ float bf_hi(unsigned u) { return __uint_as_float(u & 0xffff0000u); }
__device__ __forceinline__ float sigmoid_f(float x) { return __builtin_amdgcn_rcpf(1.0f + __builtin_amdgcn_exp2f(-1.4426950408889634f * x)); }
__device__ __forceinline__ float silu_f(float x) { return x * sigmoid_f(x); }
__device__ __forceinline__ float gelu_f(float x) { const float t = x * (1.5957691216057308f + 0.07135481627f * x * x); return x * sigmoid_f(t); }
__device__ __forceinline__ f32x4 exp2_4(const f32x4 x) { return (f32x4){__builtin_amdgcn_exp2f(x.x), __builtin_amdgcn_exp2f(x.y), __builtin_amdgcn_exp2f(x.z), __builtin_amdgcn_exp2f(x.w)}; }
__device__ __forceinline__ f32x4 rcp_4(const f32x4 x) { return (f32x4){__builtin_amdgcn_rcpf(x.x), __builtin_amdgcn_rcpf(x.y), __builtin_amdgcn_rcpf(x.z), __builtin_amdgcn_rcpf(x.w)}; }
__device__ __forceinline__ f32x4 sigmoid4(const f32x4 x) { return rcp_4(exp2_4(x * -1.4426950408889634f) + 1.0f); }
__device__ __forceinline__ f32x4 gelu4(const f32x4 x) { const f32x4 t = x * (x * x * 0.07135481627f + 1.5957691216057308f); return x * sigmoid4(t); }
__device__ __forceinline__ u32x4 pack8(const f32x4& v0, const f32x4& v1) { u32x4 w; w.x = cvt_pk_bf16(v0[0], v0[1]); w.y = cvt_pk_bf16(v0[2], v0[3]); w.z = cvt_pk_bf16(v1[0], v1[1]); w.w = cvt_pk_bf16(v1[2], v1[3]); return w; }

#ifndef EPI_PROBE
#define EPI_PROBE 0
#endif
#ifndef EPI_NT
#define EPI_NT 0
#endif
#ifndef EPI_WT
#define EPI_WT 0
#endif
__device__ __forceinline__ void st16(void* p, u32x4 v) {
#if EPI_WT
    asm volatile("global_store_dwordx4 %0, %1, off sc1\n\ts_nop 1" :: "v"(p), "v"(v) : "memory");
#elif EPI_NT
    __builtin_nontemporal_store(v, (u32x4*)p);
#else
    *(u32x4*)p = v;
#endif
}
__device__ __forceinline__ void st8(void* p, u32x2 v) {
#if EPI_WT
    asm volatile("global_store_dwordx2 %0, %1, off sc1" :: "v"(p), "v"(v) : "memory");
#elif EPI_NT
    __builtin_nontemporal_store(v, (u32x2*)p);
#else
    *(u32x2*)p = v;
#endif
}
struct EpiPlain {
    static constexpr int NSTORE = 16;
    static constexpr bool PERM = true, AFTER_DRAIN = false;
    bf16_t* O; int ldc; int nNloc;
    __device__ __forceinline__ void operator()(const f32x4 (&acc)[2][2][4][2], const Unit& u, int wr, int wc, int fr, int fq) const {
        const int row0 = u.pm * BM + wr * 64 + fr, col0 = (u.pn % nNloc) * BM + wc * 32 + 8 * fq;
#pragma unroll
        for (int ai = 0; ai < 2; ++ai)
#pragma unroll
            for (int m = 0; m < 4; ++m) { bf16_t* rowp = O + (size_t)(row0 + ai * HALF + m * 16) * ldc + col0;
#pragma unroll
                for (int bj = 0; bj < 2; ++bj) st16(rowp + bj * HALF, pack8(acc[ai][bj][m][0], acc[ai][bj][m][1])); }
    }
};
struct EpiIn0 {
    static constexpr int NSTORE = 16;
    static constexpr bool PERM = true, AFTER_DRAIN = false;
    bf16_t* ussm; size_t dstride; const float* sA; const float* sB;
    __device__ __forceinline__ void operator()(const f32x4 (&acc)[2][2][4][2], const Unit& u, int wr, int wc, int fr, int fq) const {
        const int dest = u.pn >> 1; bf16_t* base = ussm + (size_t)dest * dstride;
        const int row0 = u.pm * BM + wr * 64 + fr, col0 = (u.pn & 1) * BM + wc * 32 + 8 * fq, cb = u.pn * BM + wc * 32 + 8 * fq;
        f32x4 sb[2][2];
#pragma unroll
        for (int bj = 0; bj < 2; ++bj) { sb[bj][0] = *(const f32x4*)(sB + cb + bj * HALF); sb[bj][1] = *(const f32x4*)(sB + cb + bj * HALF + 4); }
#pragma unroll
        for (int ai = 0; ai < 2; ++ai)
#pragma unroll
            for (int m = 0; m < 4; ++m) { const float ra = sA[row0 + ai * HALF + m * 16]; bf16_t* rowp = base + (size_t)(row0 + ai * HALF + m * 16) * 512 + col0;
#pragma unroll
                for (int bj = 0; bj < 2; ++bj) { f32x4 v0 = __builtin_convertvector(__builtin_bit_cast(v4i_t, acc[ai][bj][m][0]), f32x4) * (sb[bj][0] * ra), v1 = __builtin_convertvector(__builtin_bit_cast(v4i_t, acc[ai][bj][m][1]), f32x4) * (sb[bj][1] * ra);
                    if (dest) { v0 = gelu4(v0); v1 = gelu4(v1); }
                    st16(rowp + bj * HALF, pack8(v0, v1)); } }
    }
};
struct EpiGlu {
    static constexpr int NSTORE = 16;
    static constexpr bool PERM = true, AFTER_DRAIN = false;
    const bf16_t* Y; bf16_t* O;
    __device__ __forceinline__ void operator()(const f32x4 (&acc)[2][2][4][2], const Unit& u, int wr, int wc, int fr, int fq) const {
        const int row0 = u.pm * BM + wr * 64 + fr, col0 = u.pn * BM + wc * 32 + 8 * fq;
#pragma unroll
        for (int ai = 0; ai < 2; ++ai)
#pragma unroll
            for (int m = 0; m < 4; ++m) { const size_t r = (size_t)(row0 + ai * HALF + m * 16);
#pragma unroll
                for (int bj = 0; bj < 2; ++bj) { const u32x4 y = *(const u32x4*)(Y + r * 512 + col0 + bj * HALF);
                    const f32x4 y0 = {bf_lo(y.x), bf_hi(y.x), bf_lo(y.y), bf_hi(y.y)}, y1 = {bf_lo(y.z), bf_hi(y.z), bf_lo(y.w), bf_hi(y.w)};
                    const f32x4 v0 = y0 * sigmoid4(acc[ai][bj][m][0]), v1 = y1 * sigmoid4(acc[ai][bj][m][1]);
                    st16(O + r * 1024 + col0 + bj * HALF, pack8(v0, v1)); } }
    }
};
struct EpiSwiGlu {
    static constexpr int NSTORE = 8;
    static constexpr bool PERM = true, AFTER_DRAIN = false;
    bf16_t* O; int ldo; int nNloc; const float* rstd;
    __device__ __forceinline__ void operator()(const f32x4 (&acc)[2][2][4][2], const Unit& u, int wr, int wc, int fr, int fq) const {
        const int row0 = u.pm * BM + wr * 64 + fr, col0 = (u.pn % nNloc) * HALF + wc * 32 + 8 * fq;
#pragma unroll
        for (int ai = 0; ai < 2; ++ai)
#pragma unroll
            for (int m = 0; m < 4; ++m) { const int row = row0 + ai * HALF + m * 16; const float rs = rstd[row];
                const float c1 = -1.4426950408889634f * rs, rs2 = rs * rs; const f32x4 g0 = acc[ai][0][m][0], g1 = acc[ai][0][m][1];
                const f32x4 v0 = (g0 * acc[ai][1][m][0]) * (rcp_4(exp2_4(g0 * c1) + 1.0f) * rs2), v1 = (g1 * acc[ai][1][m][1]) * (rcp_4(exp2_4(g1 * c1) + 1.0f) * rs2);
                st16(O + (size_t)row * ldo + col0, pack8(v0, v1)); }
    }
};
struct EpiSwiGluI8 {
    static constexpr int NSTORE = 8;
    static constexpr bool PERM = true, AFTER_DRAIN = false;
    bf16_t* O; int ldo; int nNloc; const float* sA; const float* sB;
    __device__ __forceinline__ void operator()(const f32x4 (&acc)[2][2][4][2], const Unit& u, int wr, int wc, int fr, int fq) const {
        const int row0 = u.pm * BM + wr * 64 + fr, col0 = (u.pn % nNloc) * HALF + wc * 32 + 8 * fq, cb = u.pn * BM + wc * 32 + 8 * fq;
        const f32x4 sg0 = *(const f32x4*)(sB + cb), sg1 = *(const f32x4*)(sB + cb + 4), su0 = *(const f32x4*)(sB + cb + HALF), su1 = *(const f32x4*)(sB + cb + HALF + 4);
#if EPI_PROBE == 2
        for (int rep = 0; rep < 2; ++rep) { asm volatile("" ::: "memory");
#endif
#pragma unroll
        for (int ai = 0; ai < 2; ++ai)
#pragma unroll
            for (int m = 0; m < 4; ++m) { const int row = row0 + ai * HALF + m * 16; const float a = sA[row];
                const f32x4 g0 = __builtin_convertvector(__builtin_bit_cast(v4i_t, acc[ai][0][m][0]), f32x4) * (sg0 * a), g1 = __builtin_convertvector(__builtin_bit_cast(v4i_t, acc[ai][0][m][1]), f32x4) * (sg1 * a);
                const f32x4 u0 = __builtin_convertvector(__builtin_bit_cast(v4i_t, acc[ai][1][m][0]), f32x4) * (su0 * a), u1 = __builtin_convertvector(__builtin_bit_cast(v4i_t, acc[ai][1][m][1]), f32x4) * (su1 * a);
                const f32x4 v0 = (g0 * u0) * sigmoid4(g0), v1 = (g1 * u1) * sigmoid4(g1);
                st16(O + (size_t)row * ldo + col0, pack8(v0, v1)); }
#if EPI_PROBE == 2
        }
#endif
    }
};
__device__ __forceinline__ unsigned pk4_fp8(float a, float b, float c, float d) { unsigned w = 0u; w = __builtin_amdgcn_cvt_pk_fp8_f32(a, b, w, false); w = __builtin_amdgcn_cvt_pk_fp8_f32(c, d, w, true); return w; }
__device__ __forceinline__ float clamp448(float x) { return __builtin_fminf(__builtin_fmaxf(x, -448.f), 448.f); }
struct EpiSwiGlu8 {
    static constexpr int NSTORE = 8;
    static constexpr bool PERM = true, AFTER_DRAIN = false;
    unsigned char* O; int ldo; int nNloc; float hs;
    __device__ __forceinline__ void operator()(const f32x4 (&acc)[2][2][4][2], const Unit& u, int wr, int wc, int fr, int fq) const {
#if EPI_PROBE == 1
        for (int rep = 0; rep < 2; ++rep) { asm volatile("" ::: "memory");
#endif
        const int row0 = u.pm * BM + wr * 64 + fr, col0 = (u.pn % nNloc) * HALF + wc * 32 + 8 * fq;
#pragma unroll
        for (int ai = 0; ai < 2; ++ai)
#pragma unroll
            for (int m = 0; m < 4; ++m) { const f32x4 g0 = acc[ai][0][m][0], g1 = acc[ai][0][m][1];
                f32x4 v0 = (g0 * acc[ai][1][m][0]) * (rcp_4(exp2_4(g0 * -1.4426950408889634f) + 1.0f) * hs), v1 = (g1 * acc[ai][1][m][1]) * (rcp_4(exp2_4(g1 * -1.4426950408889634f) + 1.0f) * hs);
                v0 = __builtin_elementwise_min(__builtin_elementwise_max(v0, (f32x4){-448.f, -448.f, -448.f, -448.f}), (f32x4){448.f, 448.f, 448.f, 448.f});
                v1 = __builtin_elementwise_min(__builtin_elementwise_max(v1, (f32x4){-448.f, -448.f, -448.f, -448.f}), (f32x4){448.f, 448.f, 448.f, 448.f});
                u32x2 w; w.x = pk4_fp8(v0.x, v0.y, v0.z, v0.w); w.y = pk4_fp8(v1.x, v1.y, v1.z, v1.w);
                st8(O + (size_t)(row0 + ai * HALF + m * 16) * ldo + col0, w); }
#if EPI_PROBE == 1
        }
#endif
    }
};
struct EpiIn1 {
    static constexpr int NSTORE = 8;
    static constexpr bool PERM = true, AFTER_DRAIN = false;
    bf16_t* hglu; bf16_t* cq; size_t cstride; const float* sA; const float* sB;
    __device__ __forceinline__ void operator()(const f32x4 (&acc)[2][2][4][2], const Unit& u, int wr, int wc, int fr, int fq) const {
        const int row0 = u.pm * BM + wr * 64 + fr, cb = u.pn * BM + wc * 32 + 8 * fq;
        f32x4 sb[2][2];
#pragma unroll
        for (int bj = 0; bj < 2; ++bj) { sb[bj][0] = *(const f32x4*)(sB + cb + bj * HALF); sb[bj][1] = *(const f32x4*)(sB + cb + bj * HALF + 4); }
        if (u.pn < 4) {
            const int col0 = u.pn * HALF + wc * 32 + 8 * fq;
#pragma unroll
            for (int ai = 0; ai < 2; ++ai)
#pragma unroll
                for (int m = 0; m < 4; ++m) { const float ra = sA[row0 + ai * HALF + m * 16];
                    const f32x4 a0 = __builtin_convertvector(__builtin_bit_cast(v4i_t, acc[ai][0][m][0]), f32x4) * (sb[0][0] * ra), a1 = __builtin_convertvector(__builtin_bit_cast(v4i_t, acc[ai][0][m][1]), f32x4) * (sb[0][1] * ra);
                    const f32x4 g0 = __builtin_convertvector(__builtin_bit_cast(v4i_t, acc[ai][1][m][0]), f32x4) * (sb[1][0] * ra), g1 = __builtin_convertvector(__builtin_bit_cast(v4i_t, acc[ai][1][m][1]), f32x4) * (sb[1][1] * ra);
                    const f32x4 v0 = a0 * sigmoid4(g0), v1 = a1 * sigmoid4(g1);
                    st16(hglu + (size_t)(row0 + ai * HALF + m * 16) * 512 + col0, pack8(v0, v1)); }
        } else {
            bf16_t* base = cq + (size_t)(u.pn - 4) * cstride; const int col0 = wc * 32 + 8 * fq;
#pragma unroll
            for (int ai = 0; ai < 2; ++ai)
#pragma unroll
                for (int m = 0; m < 4; ++m) { const float ra = sA[row0 + ai * HALF + m * 16]; bf16_t* rowp = base + (size_t)(row0 + ai * HALF + m * 16) * 256 + col0;
#pragma unroll
                    for (int bj = 0; bj < 2; ++bj) st16(rowp + bj * HALF, pack8(__builtin_convertvector(__builtin_bit_cast(v4i_t, acc[ai][bj][m][0]), f32x4) * (sb[bj][0] * ra), __builtin_convertvector(__builtin_bit_cast(v4i_t, acc[ai][bj][m][1]), f32x4) * (sb[bj][1] * ra))); }
        }
    }
};
struct EpiQ {
    static constexpr int NSTORE = 32;
    static constexpr bool PERM = false, AFTER_DRAIN = false;
    bf16_t* Q; const float* cs;
    float c2;
    __device__ __forceinline__ void operator()(const f32x4 (&acc)[2][2][4][2], const Unit& u, int wr, int wc, int fr, int fq) const {
        const int row0 = u.pm * BM + wr * 64 + fr;
#pragma unroll
        for (int ai = 0; ai < 2; ++ai)
#pragma unroll
            for (int m = 0; m < 4; ++m) { const int row = row0 + ai * HALF + m * 16; const float rs = c2; const float* csr = cs + (size_t)(row & 4095) * 32 + 4 * fq;
                const f32x4 co = *(const f32x4*)csr, si = *(const f32x4*)(csr + 16);
#pragma unroll
                for (int bj = 0; bj < 2; ++bj) { const int g32 = 8 * u.pn + 4 * bj + wc; f32x4 x0 = acc[ai][bj][m][0], x1 = acc[ai][bj][m][1];
                    if (g32 % 3 == 2) { const f32x4 y0 = x0 * co - x1 * si, y1 = x1 * co + x0 * si; x0 = y0; x1 = y1; }
                    x0 = x0 * rs; x1 = x1 * rs;
                    bf16_t* p = Q + (size_t)row * 768 + u.pn * BM + bj * HALF + wc * 32 + 4 * fq;
                    u32x2 w0, w1; w0.x = cvt_pk_bf16(x0[0], x0[1]); w0.y = cvt_pk_bf16(x0[2], x0[3]); w1.x = cvt_pk_bf16(x1[0], x1[1]); w1.y = cvt_pk_bf16(x1[2], x1[3]);
                    st8(p, w0); st8(p + 16, w1); }
                asm volatile("" ::: "memory"); }
    }
};
struct EpiKV {
    static constexpr int NSTORE = 16;
    static constexpr bool PERM = true, AFTER_DRAIN = false;
    bf16_t* KK; bf16_t* VV;
    __device__ __forceinline__ void operator()(const f32x4 (&acc)[2][2][4][2], const Unit& u, int wr, int wc, int fr, int fq) const {
        const int row0 = u.pm * BM + wr * 64 + fr;
#pragma unroll
        for (int ai = 0; ai < 2; ++ai)
#pragma unroll
            for (int m = 0; m < 4; ++m) { const int row = row0 + ai * HALF + m * 16;
#pragma unroll
                for (int bj = 0; bj < 2; ++bj) { const int h = 2 * u.pn + bj; const f32x4 v0 = acc[ai][bj][m][0], v1 = acc[ai][bj][m][1];
                    bf16_t* p = wc < 2 ? KK + (size_t)row * 768 + h * 96 + wc * 32 + 8 * fq : VV + (size_t)row * 512 + h * 64 + (wc - 2) * 32 + 8 * fq;
                    st16(p, pack8(v0, v1)); }
                asm volatile("" ::: "memory"); }
    }
};
struct TileOrder {
    int nM, nN, nwg, G, c, t0; int tp1, tp2, tp3, tp4, tp5, tp6, tp7; bool grouped;
    __device__ void init(int nM_, int nN_, int G_, int c_, int t0_) { nM = nM_; nN = nN_; nwg = nM * nN; G = G_; c = c_; t0 = t0_; grouped = false; tp1 = tp2 = tp3 = tp4 = tp5 = tp6 = tp7 = 0; }
    __device__ bool next(int i, Unit& u) const {
        const long L = (long)i * G + c; if (L >= nwg) return false;
        int wgid = (int)L; { const int q = nwg / NXCD, r = nwg % NXCD, xcd = wgid % NXCD, off = wgid / NXCD; wgid = (xcd < r ? xcd * (q + 1) : r * (q + 1) + (xcd - r) * q) + off; }
        const int nig = WGM * nN, gid = wgid / nig, fm = gid * WGM, gsz = (nM - fm) < WGM ? (nM - fm) : WGM;
        const int pm = t0 + fm + ((wgid % nig) % gsz), pn = (wgid % nig) / gsz;
        u.pm = pm; u.pn = pn;
        if (grouped) { const int e = (pm >= tp1) + (pm >= tp2) + (pm >= tp3) + (pm >= tp4) + (pm >= tp5) + (pm >= tp6) + (pm >= tp7); u.pn = e * nN + pn; }
        return true;
    }
    __device__ __forceinline__ void a_ready(const Unit&) const {}
    __device__ __forceinline__ void done(const Unit&) const {}
};
template <class Epi, class Sched, bool ALIGN_EPI = false, bool SP2 = false, int QM = 0>
__device__ __forceinline__ void gemm_phase(PG8_LAS unsigned char* lds, const Gemm g, const Sched& S, const Epi& E) {
    const int tid = threadIdx.x, wid = __builtin_amdgcn_readfirstlane(tid >> 6), lane = tid & 63, wr = wid >> 2, wc = wid & 3, fr = lane & 15, fq = lane >> 4;
    int K_ = g.K; asm volatile("" : "+s"(K_));
    const int K = K_, nt = K / (QM ? 2 * BK : BK), RB = QM ? K : 2 * K;
    unsigned voffA[2], voffB[2];
#pragma unroll
    for (int i = 0; i < 2; ++i) { int R, C; stage_rc(tid * 16 + i * 8192, R, C); const int Rb = Epi::PERM ? ((R & ~31) + perm32(R & 31)) : R;
        voffA[i] = (unsigned)(R * RB + C * 2); voffB[i] = (unsigned)(Rb * RB + C * 2); }
    const size_t kstep = (size_t)(BK * 2);
    const size_t hstep = (size_t)HALF * RB;
    const size_t tstep = 2 * hstep;
    const unsigned ldsw = (unsigned)wid * 1024u;
    const int aoff = lds_byte(wr * 64 + fr, fq * 8), boff = lds_byte(wc * 32 + fr, fq * 8);
#define PG8_SA(b, h) (((b) * 2 + (h)) * HTB)
#define PG8_SB(b, h) ((4 + (b) * 2 + (h)) * HTB)
#define PG8_STAGE(bufoff, gbase, voff) do { _Pragma("unroll") for (int _i = 0; _i < 2; ++_i) \
        __builtin_amdgcn_global_load_lds((const unsigned*)((const char*)(gbase) + (voff)[_i]), (PG8_LAS unsigned*)(lds + (bufoff) + ldsw + _i * 8192), 16, 0, 0); } while (0)
#define PG8_LDA(dst, b, h) do { if constexpr (QM == 1) { _Pragma("unroll") for (int m = 0; m < 4; ++m) dst##8[m] = __builtin_shufflevector(*(const PG8_LAS v4i_t*)(lds + PG8_SA(b, h) + aoff + m * 2048), *(const PG8_LAS v4i_t*)(lds + PG8_SA(b, h) + aoff + m * 2048 + 1024), 0, 1, 2, 3, 4, 5, 6, 7); } \
        else { _Pragma("unroll") for (int m = 0; m < 4; ++m) _Pragma("unroll") for (int k = 0; k < 2; ++k) dst[m][k] = *(const PG8_LAS bf16x8*)(lds + PG8_SA(b, h) + aoff + m * 2048 + k * 1024); } } while (0)
#define PG8_LDB(dst, b, h) do { if constexpr (QM == 1) { _Pragma("unroll") for (int n = 0; n < 2; ++n) dst##8[n] = __builtin_shufflevector(*(const PG8_LAS v4i_t*)(lds + PG8_SB(b, h) + boff + n * 2048), *(const PG8_LAS v4i_t*)(lds + PG8_SB(b, h) + boff + n * 2048 + 1024), 0, 1, 2, 3, 4, 5, 6, 7); } \
        else { _Pragma("unroll") for (int n = 0; n < 2; ++n) _Pragma("unroll") for (int k = 0; k < 2; ++k) dst[n][k] = *(const PG8_LAS bf16x8*)(lds + PG8_SB(b, h) + boff + n * 2048 + k * 1024); } } while (0)
#define PG8_MMA(ai, bj, At, Bt) do { __builtin_amdgcn_s_setprio(1); \
        if constexpr (QM == 2) { _Pragma("unroll") for (int m = 0; m < 4; ++m) _Pragma("unroll") for (int n = 0; n < 2; ++n) _Pragma("unroll") for (int k = 0; k < 2; ++k) \
            acc[ai][bj][m][n] = __builtin_bit_cast(f32x4, __builtin_amdgcn_mfma_i32_16x16x64_i8(__builtin_bit_cast(v4i_t, Bt[n][k]), __builtin_bit_cast(v4i_t, At[m][k]), __builtin_bit_cast(v4i_t, acc[ai][bj][m][n]), 0, 0, 0)); } \
        else if constexpr (QM == 1) { _Pragma("unroll") for (int m = 0; m < 4; ++m) _Pragma("unroll") for (int n = 0; n < 2; ++n) \
            asm volatile("v_mfma_scale_f32_16x16x128_f8f6f4 %0, %1, %2, %0, %3, %4 op_sel_hi:[0,0,0]" : "+v"(acc[ai][bj][m][n]) : "v"(Bt##8[n]), "v"(At##8[m]), "v"(vsb), "v"(vsa)); } \
        else { _Pragma("unroll") for (int m = 0; m < 4; ++m) _Pragma("unroll") for (int n = 0; n < 2; ++n) _Pragma("unroll") for (int k = 0; k < 2; ++k) \
            acc[ai][bj][m][n] = __builtin_amdgcn_mfma_f32_16x16x32_bf16(Bt[n][k], At[m][k], acc[ai][bj][m][n], 0, 0, 0); } \
        __builtin_amdgcn_s_setprio(0); } while (0)
#define PG8_WAIT_V(n) asm volatile("s_waitcnt vmcnt(" #n ")" ::: "memory")
#define PG8_WAIT_L(n) asm volatile("s_waitcnt lgkmcnt(" #n ")" ::: "memory")
#define PG8_BAR __builtin_amdgcn_s_barrier()
#define PG8_SCHED __builtin_amdgcn_sched_barrier(0)
#define PG8_WAIT_VR() asm volatile("s_cmp_eq_u32 %0, 0\n\ts_cbranch_scc1 2\n\ts_waitcnt vmcnt(%1)\n\ts_branch 1\n\ts_waitcnt vmcnt(8)" :: "s"(relax), "n"(8 + Epi::NSTORE) : "memory", "scc")
    int vsa = g.sa, vsb = g.sb; if constexpr (QM == 1) { asm volatile("" : "+v"(vsa), "+v"(vsb)); }
    Unit cur, nxt; int ui = 0;
    if (!S.next(0, cur)) return;
    f32x4 acc[2][2][4][2];
#pragma unroll
    for (int a = 0; a < 2; ++a)
#pragma unroll
        for (int b = 0; b < 2; ++b)
#pragma unroll
            for (int m = 0; m < 4; ++m)
#pragma unroll
                for (int n = 0; n < 2; ++n) acc[a][b][m][n] = (f32x4){0.f, 0.f, 0.f, 0.f};
    bf16x8 At[4][2], B0[2][2], B1[2][2]; v8i_t At8[4], B08[2], B18[2];
    const char* cA = (const char*)g.A + (size_t)cur.pm * tstep; const char* cB = (const char*)g.Bt + (size_t)cur.pn * tstep;
    S.a_ready(cur);
    if constexpr (SP2) {
        PG8_STAGE(PG8_SB(0, 0), cB, voffB); PG8_STAGE(PG8_SB(0, 1), cB + hstep, voffB); PG8_STAGE(PG8_SA(0, 0), cA, voffA); PG8_STAGE(PG8_SA(0, 1), cA + hstep, voffA);
        if (wr == 1) PG8_BAR;
        PG8_WAIT_V(2); PG8_BAR;
        PG8_STAGE(PG8_SB(1, 0), cB + kstep, voffB); PG8_STAGE(PG8_SA(1, 0), cA + kstep, voffA); PG8_STAGE(PG8_SB(1, 1), cB + hstep + kstep, voffB);
        PG8_WAIT_V(6); PG8_BAR;
    } else {
        PG8_STAGE(PG8_SB(0, 0), cB, voffB); PG8_STAGE(PG8_SA(0, 0), cA, voffA); PG8_STAGE(PG8_SB(0, 1), cB + hstep, voffB); PG8_STAGE(PG8_SA(0, 1), cA + hstep, voffA);
        if (wr == 1) PG8_BAR;
        PG8_WAIT_V(4); PG8_BAR;
        PG8_STAGE(PG8_SB(1, 0), cB + kstep, voffB); PG8_STAGE(PG8_SA(1, 0), cA + kstep, voffA); PG8_STAGE(PG8_SB(1, 1), cB + hstep + kstep, voffB);
        PG8_WAIT_V(6); PG8_BAR;
    }
    for (;;) {
        const bool has_next = S.next(ui + 1, nxt);
        const char* nA = has_next ? (const char*)g.A + (size_t)nxt.pm * tstep : cA; const char* nB = has_next ? (const char*)g.Bt + (size_t)nxt.pn * tstep : cB;
        for (int t = 0; t < nt; t += 2) {
            const bool last = (t == nt - 2);
            const char* a1 = cA + (size_t)(t + 1) * kstep;
            const char* a2 = last ? nA : cA + (size_t)(t + 2) * kstep; const char* b2 = last ? nB : cB + (size_t)(t + 2) * kstep;
            const char* a3 = a2 + kstep; const char* b3 = b2 + kstep;
            if (last && has_next) S.a_ready(nxt);
            if constexpr (SP2) {
            const int relax = __builtin_amdgcn_readfirstlane((t == 0 && ui > 0) ? 1 : 0);
            PG8_LDB(B0, 0, 0); PG8_LDB(B1, 0, 1); PG8_SCHED; PG8_LDA(At, 0, 0); PG8_STAGE(PG8_SA(1, 1), a1 + hstep, voffA);
            PG8_WAIT_VR(); PG8_WAIT_L(0); PG8_BAR; PG8_MMA(0, 0, At, B0); PG8_MMA(0, 1, At, B1); PG8_BAR; PG8_SCHED;
            PG8_LDA(At, 0, 1); PG8_STAGE(PG8_SB(0, 0), b2, voffB); PG8_STAGE(PG8_SB(0, 1), b2 + hstep, voffB); PG8_STAGE(PG8_SA(0, 0), a2, voffA);
            PG8_WAIT_VR(); PG8_WAIT_L(0); PG8_BAR; PG8_MMA(1, 0, At, B0); PG8_MMA(1, 1, At, B1); PG8_BAR; PG8_SCHED;
            PG8_LDB(B0, 1, 0); PG8_LDB(B1, 1, 1); PG8_SCHED; PG8_LDA(At, 1, 0); PG8_STAGE(PG8_SA(0, 1), a2 + hstep, voffA);
            PG8_WAIT_V(8); PG8_WAIT_L(0); PG8_BAR; PG8_MMA(0, 0, At, B0); PG8_MMA(0, 1, At, B1); PG8_BAR; PG8_SCHED;
            PG8_LDA(At, 1, 1); PG8_STAGE(PG8_SB(1, 0), b3, voffB); PG8_STAGE(PG8_SB(1, 1), b3 + hstep, voffB); PG8_STAGE(PG8_SA(1, 0), a3, voffA);
            PG8_WAIT_V(8); PG8_WAIT_L(0); PG8_BAR; PG8_MMA(1, 0, At, B0); PG8_MMA(1, 1, At, B1); PG8_BAR; PG8_SCHED;
            } else {
            PG8_LDB(B0, 0, 0); PG8_SCHED; PG8_LDA(At, 0, 0); PG8_STAGE(PG8_SA(1, 1), a1 + hstep, voffA);
            PG8_WAIT_L(8); PG8_BAR; PG8_WAIT_L(0); PG8_MMA(0, 0, At, B0); PG8_BAR; PG8_SCHED;
            PG8_LDB(B1, 0, 1); PG8_STAGE(PG8_SB(0, 0), b2, voffB);
            PG8_BAR; PG8_WAIT_L(0); PG8_MMA(0, 1, At, B1); PG8_BAR;
            PG8_LDA(At, 0, 1); PG8_STAGE(PG8_SA(0, 0), a2, voffA);
            PG8_BAR; PG8_WAIT_L(0); PG8_MMA(1, 0, At, B0); PG8_BAR; PG8_SCHED;
            PG8_STAGE(PG8_SB(0, 1), b2 + hstep, voffB);
            PG8_WAIT_V(6); PG8_BAR; PG8_MMA(1, 1, At, B1); PG8_BAR;
            PG8_LDB(B0, 1, 0); PG8_SCHED; PG8_LDA(At, 1, 0); PG8_STAGE(PG8_SA(0, 1), a2 + hstep, voffA);
            PG8_WAIT_L(8); PG8_BAR; PG8_WAIT_L(0); PG8_MMA(0, 0, At, B0); PG8_BAR; PG8_SCHED;
            PG8_LDB(B1, 1, 1); PG8_STAGE(PG8_SB(1, 0), b3, voffB);
            PG8_BAR; PG8_WAIT_L(0); PG8_MMA(0, 1, At, B1); PG8_BAR;
            PG8_LDA(At, 1, 1); PG8_STAGE(PG8_SA(1, 0), a3, voffA);
            PG8_BAR; PG8_WAIT_L(0); PG8_MMA(1, 0, At, B0); PG8_BAR; PG8_SCHED;
            PG8_STAGE(PG8_SB(1, 1), b3 + hstep, voffB);
            PG8_WAIT_V(6); PG8_BAR; PG8_MMA(1, 1, At, B1); PG8_BAR;
            }
        }
        if constexpr (QM == 1) { asm volatile("s_nop 15\n\ts_nop 15\n\ts_nop 7" ::: "memory"); }
        if constexpr (ALIGN_EPI) { if (wr == 0) PG8_BAR; }
        if constexpr (!Epi::AFTER_DRAIN) { E(acc, cur, wr, wc, fr, fq); S.done(cur); }
        if (!has_next) break;
#pragma unroll
        for (int a = 0; a < 2; ++a)
#pragma unroll
            for (int b = 0; b < 2; ++b)
#pragma unroll
                for (int m = 0; m < 4; ++m)
#pragma unroll
                    for (int n = 0; n < 2; ++n) acc[a][b][m][n] = (f32x4){0.f, 0.f, 0.f, 0.f};
        cur = nxt; cA = nA; cB = nB; ++ui;
        if constexpr (ALIGN_EPI) { if (wr == 1) PG8_BAR; }
    }
    PG8_WAIT_V(0);
    if constexpr (!ALIGN_EPI) { if (wr == 0) PG8_BAR; }
    PG8_BAR;
    if constexpr (Epi::AFTER_DRAIN) { E.fused(acc, cur, wr, wc, fr, fq, lds, wid, lane); S.done(cur); }
#undef PG8_SA
#undef PG8_SB
#undef PG8_STAGE
#undef PG8_LDA
#undef PG8_LDB
#undef PG8_MMA
#undef PG8_WAIT_V
#undef PG8_WAIT_L
#undef PG8_BAR
#undef PG8_SCHED
#undef PG8_WAIT_VR
}
}

constexpr int NT = 16384, DM = 1024, SEQ = 4096;
constexpr int NWAVES = 8, NTHR = 512;
constexpr float NORM_EPS = 1e-6f;
constexpr size_t MiB = 1u << 20;
constexpr size_t WS_CTL = 0, CTL_ZERO_BYTES = 1 * MiB;
constexpr size_t WS_ROPE = 1 * MiB;
constexpr size_t WS_SSM_B = WS_ROPE + 512 * 1024;
constexpr size_t WS_SSM_C = WS_SSM_B + 128 * 1024;
constexpr size_t WS_SSM_L = WS_SSM_C + 128 * 1024;
constexpr size_t WS_RSTDQ = 2 * MiB;
constexpr size_t WS_RSTDKV = WS_RSTDQ + 64 * 1024;
constexpr size_t WS_TOKE = WS_RSTDKV + 64 * 1024;
constexpr size_t WS_TOKW = WS_TOKE + 128 * 1024;
constexpr size_t WS_TOKR = WS_TOKW + 128 * 1024;
constexpr size_t WS_BCNT = WS_TOKR + 128 * 1024;
constexpr size_t WS_META = WS_BCNT + 8 * 1024;
constexpr size_t WS_SB = WS_BCNT + 16 * 1024;
constexpr size_t WS_SB0 = WS_SB + 32 * 1024, WS_SB1 = WS_SB + 40 * 1024;
constexpr size_t WS_SA = WS_RSTDKV;
constexpr size_t WS_WIN0 = 8 * MiB;
constexpr size_t WS_WGLU = WS_WIN0 + 3 * MiB;
constexpr size_t WS_WOUT0 = WS_WGLU + MiB / 2;
constexpr size_t WS_WGU0 = WS_WOUT0 + 2 * MiB;
constexpr size_t WS_WDN0 = WS_WGU0 + 16 * MiB;
constexpr size_t WS_WIN1 = WS_WDN0 + 8 * MiB;
constexpr size_t WS_WUQ = WS_WIN1 + 3 * MiB;
constexpr size_t WS_WUKV = WS_WUQ + 384 * 1024;
constexpr size_t WS_WOUT1 = WS_WUKV + MiB / 2;
constexpr size_t WS_WGU1 = WS_WOUT1 + 2 * MiB;
constexpr size_t WS_WDN1 = WS_WGU1 + 56 * MiB;
constexpr size_t WS_H = WS_WDN1 + 28 * MiB;
constexpr size_t WS_Z = WS_H + 64 * MiB;
constexpr size_t WS_MIX = WS_Z + 32 * MiB;
constexpr size_t WS_T = WS_MIX + 32 * MiB;
constexpr size_t WS_USSM = WS_T, WS_GU = WS_T + 16 * MiB, WS_GV = WS_T + 32 * MiB, WS_YB = WS_T + 48 * MiB, WS_MIXCAT0 = WS_T + 64 * MiB;
constexpr size_t WS_HFF = WS_T;
constexpr size_t WS_HGLU = WS_T, WS_CQ = WS_T + 16 * MiB, WS_CKV = WS_T + 24 * MiB, WS_Q = WS_T + 32 * MiB, WS_KK = WS_T + 56 * MiB, WS_VV = WS_T + 80 * MiB, WS_MIXCAT1 = WS_T + 96 * MiB;
constexpr int MOE_MAX_ROWS = 34816;
constexpr size_t WS_HOUT = WS_Z;
constexpr size_t WS_AG8 = WS_Z + 64 * MiB;
constexpr size_t WS_HMOE8 = WS_AG8 + 34 * MiB;
constexpr size_t WS_END = WS_HMOE8 + 119 * MiB;
static_assert(WS_HOUT + (size_t)MOE_MAX_ROWS * 1024 * 2 <= WS_HMOE8 && WS_AG8 + (size_t)MOE_MAX_ROWS * 1024 <= WS_HMOE8 && WS_AG8 >= WS_MIX + 32 * MiB, "moe buffers");
static_assert(WS_END >= WS_T + 128 * MiB && WS_END <= (size_t)470 * MiB, "workspace budget");
static_assert(WS_GV - WS_GU == WS_GU - WS_USSM, "EpiIn0 destinations equally spaced");
constexpr int CW_BAR = 4096;
constexpr int LDS_BYTES = 147456;
constexpr int MISC_OFF = LDS_BYTES - 512;

#define GAS __attribute__((address_space(1)))
#define LAS __attribute__((address_space(3)))
typedef unsigned short bf16;
typedef unsigned v4u __attribute__((ext_vector_type(4)));
typedef unsigned v2u __attribute__((ext_vector_type(2)));
typedef float f32x4 __attribute__((ext_vector_type(4)));
typedef short bf16x8 __attribute__((ext_vector_type(8)));
#define LDS_WAIT() asm volatile("s_waitcnt lgkmcnt(0)" ::: "memory")
#define VM_WAIT() asm volatile("s_waitcnt vmcnt(0)" ::: "memory")
using pg8::cvt_pk_bf16; using pg8::bf_lo; using pg8::bf_hi; using pg8::sigmoid_f; using pg8::gelu_f; using pg8::silu_f;
#define XB_TMO      128
#define XB_XCNT(j)  (256  + 64 * (j))
#define XB_XSUB(j)  (1280 + 64 * (j))
#define XB_XGEN(j)  (2304 + 64 * (j))
#define XB_TOP      3328
#define XB_TOPGEN   3392
#define XCD_BAR_WORDS 3456
#define XB_SPIN_CAP (1u << 18)

__device__ __forceinline__ unsigned xb_ld(unsigned* p)              { return __hip_atomic_load(p, __ATOMIC_RELAXED, __HIP_MEMORY_SCOPE_AGENT); }
__device__ __forceinline__ unsigned xb_add(unsigned* p, unsigned v) { return __hip_atomic_fetch_add(p, v, __ATOMIC_RELAXED, __HIP_MEMORY_SCOPE_AGENT); }
__device__ __forceinline__ unsigned xb_xcc_id() { return (unsigned)__builtin_amdgcn_s_getreg((3 << 11) | 20) & 0xFu; }
#define XB_SPIN(cond, bar) do { unsigned _sp = 0; while (cond) { __builtin_amdgcn_s_sleep(1); \
    if ((++_sp & 255u) == 0u) { if (xb_ld(&(bar)[XB_TMO])) break; if (_sp > XB_SPIN_CAP) { atomicAdd(&(bar)[XB_TMO], 1u); break; } } } } while (0)

struct XcdBarrier {
    unsigned* bar; unsigned x;
    volatile LAS unsigned* st;
};

__device__ __forceinline__ XcdBarrier xcd_barrier_post(unsigned* bar, volatile LAS unsigned* st) {
    XcdBarrier b; b.bar = bar; b.x = xb_xcc_id(); b.st = st;
    if (threadIdx.x == 0) (void)xb_add(&bar[XB_XCNT(b.x)], 1u);
    return b;
}
__device__ __forceinline__ void xcd_barrier_complete(unsigned* bar, unsigned x, unsigned& nloc, unsigned& nx) {
    const unsigned G = gridDim.x * gridDim.y * gridDim.z;
    unsigned sum, cnt, mine, sp = 0u;
    for (;;) {
        sum = 0u; cnt = 0u; mine = 0u;
#pragma unroll
        for (unsigned j = 0; j < 16; ++j) { const unsigned c = xb_ld(&bar[XB_XCNT(j)]); sum += c; cnt += (c > 0u) ? 1u : 0u; mine = (j == x) ? c : mine; }
        if (sum == G) break;
        __builtin_amdgcn_s_sleep(1);
        if ((++sp & 255u) == 0u) { if (xb_ld(&bar[XB_TMO])) break; if (sp > XB_SPIN_CAP) { atomicAdd(&bar[XB_TMO], 1u); break; } }
    }
    nloc = mine > 0u ? mine : 1u; nx = cnt > 0u ? cnt : 1u;
}

__device__ __forceinline__ void xcd_barrier(const XcdBarrier& b) {
    asm volatile("s_waitcnt vmcnt(0)" ::: "memory");
    __syncthreads();
    if (threadIdx.x == 0) {
        unsigned* bar = b.bar;
        __builtin_amdgcn_s_waitcnt(0);
        unsigned nloc = b.st[0], nx = b.st[1];
        if (nloc == 0u) { xcd_barrier_complete(bar, b.x, nloc, nx); b.st[0] = nloc; b.st[1] = nx; }
        const unsigned old = xb_add(&bar[XB_XSUB(b.x)], 1u);
        const unsigned gen = old / nloc;
        if (old + 1u == (gen + 1u) * nloc) {
            __builtin_amdgcn_fence(__ATOMIC_RELEASE, "agent");
            asm volatile("s_waitcnt vmcnt(0)" ::: "memory");
            const unsigned og = xb_add(&bar[XB_TOP], 1u);
            const unsigned tg = og / nx;
            if (og + 1u == (tg + 1u) * nx) xb_add(&bar[XB_TOPGEN], 1u);
            else XB_SPIN(xb_ld(&bar[XB_TOPGEN]) == tg, bar);
            __builtin_amdgcn_fence(__ATOMIC_ACQUIRE, "agent");
            xb_add(&bar[XB_XGEN(b.x)], 1u);
            asm volatile("s_waitcnt vmcnt(0)" ::: "memory");
        } else {
            XB_SPIN(xb_ld(&bar[XB_XGEN(b.x)]) == gen, bar);
            __builtin_amdgcn_fence(__ATOMIC_ACQUIRE, "agent");
            asm volatile("s_waitcnt vmcnt(0)" ::: "memory");
        }
    }
    __syncthreads();
}

struct TDesc { const float* W; bf16* WT; const float* gain; long sstride, dstride; int ldw, K, N, Kd, map, roff, nb, item0; float scale; int fp8; };
constexpr int ND = 15, ND_P0 = 12, MOE_ITEMS = 3 * 14336;
constexpr int MQ_A = 10752, MQ_B = MQ_A + 13824, MQ_C = MQ_B + 7680, MQ_D = MOE_ITEMS, MQ_SLOTS = MQ_D;
struct Args {
    const float* in[34]; float* out; unsigned char* ws;
    TDesc td[ND]; int n_items; int ph_lo, ph_hi, dbg;
};
struct Frame {
    LAS unsigned char* lds; volatile LAS unsigned* MISC; unsigned* ctl;
    int tid, lane, wave, vcu, G;
};
__device__ __forceinline__ float wave_sum(float v) {
#pragma unroll
    for (int o = 1; o < 64; o <<= 1) v += __shfl_xor(v, o);
    return v;
}
__device__ __forceinline__ unsigned pk2(float lo, float hi) { return cvt_pk_bf16(lo, hi); }
__device__ __forceinline__ float wave_max(float v) {
#pragma unroll
    for (int o = 1; o < 64; o <<= 1) v = fmaxf(v, __shfl_xor(v, o));
    return v;
}

struct P0Regs { f32x4 v[8]; float g[8]; };
__device__ __forceinline__ void p0_item_load(const TDesc& d, int item, int lane, P0Regs& R) {
    const int nblk = d.N / 32, ipb = (d.K / 64) * nblk, e = item / ipb, r = item - e * ipb, kb = r / nblk, nb = r - kb * nblk, k0 = 64 * kb, n0 = 32 * nb;
    const int lr = lane >> 3, lc = 4 * (lane & 7);
    const float* wp = d.W + (size_t)e * d.sstride + (size_t)(k0 + lr) * d.ldw + n0 + lc;
#pragma unroll
    for (int i = 0; i < 8; ++i) R.v[i] = __builtin_nontemporal_load((const f32x4*)(wp + (size_t)(8 * i) * d.ldw));
#pragma unroll
    for (int i = 0; i < 8; ++i) R.g[i] = (d.gain ? d.gain[k0 + lr + 8 * i] : 1.0f) * d.scale;
}
__device__ __forceinline__ void p0_item_store(const TDesc& d, LAS float* scr, int item, int lane, const P0Regs& R) {
    const int nblk = d.N / 32, ipb = (d.K / 64) * nblk, e = item / ipb, r = item - e * ipb, kb = r / nblk, nb = r - kb * nblk, k0 = 64 * kb, n0 = 32 * nb;
    bf16* WT = d.WT + (size_t)e * d.dstride;
    const int drow0 = d.roff + (d.map == 0 ? n0 : ((n0 >> 7) * 256 + (n0 & 127) + (d.map == 2 ? 128 : 0)));
    const int lr = lane >> 3, lc = 4 * (lane & 7);
#pragma unroll
    for (int i = 0; i < 8; ++i) { LAS float* s = scr + (lr + 8 * i) * 33 + lc; s[0] = R.v[i].x * R.g[i]; s[1] = R.v[i].y * R.g[i]; s[2] = R.v[i].z * R.g[i]; s[3] = R.v[i].w * R.g[i]; }
    LDS_WAIT(); asm volatile("" ::: "memory");
    if (d.fp8) { unsigned char* W8 = (unsigned char*)d.WT + (size_t)e * d.dstride; const int c = lane & 3;
#pragma unroll
        for (int j = 0; j < 2; ++j) { const int n = (lane >> 2) + 16 * j; const LAS float* s = scr + (16 * c) * 33 + n;
            v4u o; o.x = pg8::pk4_fp8(s[0 * 33], s[1 * 33], s[2 * 33], s[3 * 33]); o.y = pg8::pk4_fp8(s[4 * 33], s[5 * 33], s[6 * 33], s[7 * 33]);
            o.z = pg8::pk4_fp8(s[8 * 33], s[9 * 33], s[10 * 33], s[11 * 33]); o.w = pg8::pk4_fp8(s[12 * 33], s[13 * 33], s[14 * 33], s[15 * 33]);
            *(v4u*)(W8 + (size_t)(drow0 + n) * d.Kd + k0 + 16 * c) = o; }
    } else { const int c = lane & 7;
#pragma unroll
    for (int j = 0; j < 4; ++j) { const int n = (lane >> 3) + 8 * j; const LAS float* s = scr + (8 * c) * 33 + n;
        v4u o; o.x = pk2(s[0 * 33], s[1 * 33]); o.y = pk2(s[2 * 33], s[3 * 33]); o.z = pk2(s[4 * 33], s[5 * 33]); o.w = pk2(s[6 * 33], s[7 * 33]);
        *(v4u*)(WT + (size_t)(drow0 + n) * d.Kd + k0 + 8 * c) = o; } }
    LDS_WAIT(); asm volatile("" ::: "memory");
}
__device__ __forceinline__ void rms_row_to_bf16(const float* xrow, bf16* orow, int lane) {
    const f32x4* xr = (const f32x4*)xrow + lane; f32x4 v[4]; float s = 0.f;
#pragma unroll
    for (int j = 0; j < 4; ++j) { v[j] = xr[64 * j]; s += (v[j].x * v[j].x + v[j].y * v[j].y) + (v[j].z * v[j].z + v[j].w * v[j].w); }
    const float rstd = 1.0f / sqrtf(wave_sum(s) * (1.f / DM) + NORM_EPS);
    v2u* o8 = (v2u*)orow + lane;
#pragma unroll
    for (int j = 0; j < 4; ++j) { v2u w; w.x = pk2(v[j].x * rstd, v[j].y * rstd); w.y = pk2(v[j].z * rstd, v[j].w * rstd); o8[64 * j] = w; }
}
__device__ __forceinline__ unsigned pk4_i8(float a, float b, float c, float d) { return ((unsigned)(int)__builtin_rintf(a) & 255u) | (((unsigned)(int)__builtin_rintf(b) & 255u) << 8) | (((unsigned)(int)__builtin_rintf(c) & 255u) << 16) | ((unsigned)(int)__builtin_rintf(d) << 24); }
__device__ __forceinline__ void p0_i8_slab(const TDesc& d, LAS float* scr, const LAS float* inv, int n0, int kb, int lane) {
    const int lr = lane >> 3, lc = 4 * (lane & 7);
    const int drow0 = d.roff + (d.map == 0 ? n0 : ((n0 >> 7) * 256 + (n0 & 127) + (d.map == 2 ? 128 : 0)));
    const float* wp = d.W + (size_t)(64 * kb + lr) * d.ldw + n0 + lc;
    f32x4 v[8];
#pragma unroll
    for (int i = 0; i < 8; ++i) v[i] = *(const f32x4*)(wp + (size_t)(8 * i) * d.ldw);
#pragma unroll
    for (int i = 0; i < 8; ++i) { const float g = d.gain ? d.gain[64 * kb + lr + 8 * i] : 1.0f; LAS float* s = scr + (lr + 8 * i) * 33 + lc; s[0] = v[i].x * g; s[1] = v[i].y * g; s[2] = v[i].z * g; s[3] = v[i].w * g; }
    LDS_WAIT(); asm volatile("" ::: "memory");
    unsigned char* W8 = (unsigned char*)d.WT; const int c = lane & 3;
#pragma unroll
    for (int j = 0; j < 2; ++j) { const int n = (lane >> 2) + 16 * j; const LAS float* s = scr + (16 * c) * 33 + n; const float iv = inv[n];
        v4u o; o.x = pk4_i8(s[0 * 33] * iv, s[1 * 33] * iv, s[2 * 33] * iv, s[3 * 33] * iv); o.y = pk4_i8(s[4 * 33] * iv, s[5 * 33] * iv, s[6 * 33] * iv, s[7 * 33] * iv);
        o.z = pk4_i8(s[8 * 33] * iv, s[9 * 33] * iv, s[10 * 33] * iv, s[11 * 33] * iv); o.w = pk4_i8(s[12 * 33] * iv, s[13 * 33] * iv, s[14 * 33] * iv, s[15 * 33] * iv);
        *(v4u*)(W8 + (size_t)(drow0 + n) * d.Kd + 64 * kb + 16 * c) = o; }
    LDS_WAIT(); asm volatile("" ::: "memory");
}
__device__ __forceinline__ void p0_i8_block(const TDesc& d, Frame& F, int cb, float* sB) {
    const int lane = F.lane, w = F.wave, col0 = 64 * cb; const bool cok = col0 + lane < d.N;
    LAS float* cmx = (LAS float*)(F.lds + 8 * 16384);
    LAS float* inv = cmx + 512;
    { const float* wp = d.W + (size_t)(128 * w) * d.ldw + col0 + lane; float mx = 0.f;
#pragma unroll 16
      for (int k = 0; k < 128; ++k) mx = fmaxf(mx, fabsf((cok ? wp[(size_t)k * d.ldw] : 0.f) * (d.gain ? d.gain[128 * w + k] : 1.0f)));
      cmx[w * 64 + lane] = mx; }
    __syncthreads();
    if (w == 0) { float m1 = 1e-30f;
#pragma unroll
        for (int i = 0; i < 8; ++i) m1 = fmaxf(m1, cmx[i * 64 + lane]);
        const int n = col0 + lane; const int drow = d.roff + (d.map == 0 ? n : ((n >> 7) * 256 + (n & 127) + (d.map == 2 ? 128 : 0)));
        if (cok) sB[drow] = m1 * (1.0f / 127.0f); inv[lane] = 127.0f / m1; }
    __syncthreads();
    LAS float* scr = (LAS float*)(F.lds + w * 16384);
#pragma unroll 1
    for (int it = w; it < 32; it += 8) if (col0 + 32 * (it & 1) < d.N) p0_i8_slab(d, scr, inv + 32 * (it & 1), col0 + 32 * (it & 1), it >> 1, lane);
    __syncthreads();
}
__device__ __forceinline__ void moe_convert_range(const Args& a, Frame& F, int m0, int m1, int iw, int NW) {
    LAS float* scr = (LAS float*)(F.lds + F.wave * 16384);
#pragma unroll
    for (int d = 12; d < 15; ++d) { const int lo = (d - 12) * 14336, hi = lo + 14336; const int b0 = m0 > lo ? m0 : lo, b1 = m1 < hi ? m1 : hi;
        if (b0 < b1) { int it = b0 + iw; P0Regs RA, RB;
            if (it < b1) p0_item_load(a.td[d], it - lo, F.lane, RA);
            for (; it < b1; it += 2 * NW) {
                if (it + NW < b1) p0_item_load(a.td[d], it + NW - lo, F.lane, RB);
                p0_item_store(a.td[d], scr, it - lo, F.lane, RA);
                if (it + NW < b1) { if (it + 2 * NW < b1) p0_item_load(a.td[d], it + 2 * NW - lo, F.lane, RA);
                    p0_item_store(a.td[d], scr, it + NW - lo, F.lane, RB); } } } }
}
__device__ __forceinline__ void moe_convert_slot(const Args& a, Frame& F, int m0, int m1) {
    if ((int)blockIdx.x < 128 || F.G != 256) return;
    moe_convert_range(a, F, m0, m1, ((int)blockIdx.x - 128) * NWAVES + F.wave, 1024);
}
__device__ __forceinline__ void moe_convert_all(const Args& a, Frame& F) {
    if (F.G == 256) return;
    LAS float* scr = (LAS float*)(F.lds + F.wave * 16384); const int gw = (int)blockIdx.x * NWAVES + F.wave, NGW = F.G * NWAVES;
#pragma unroll
    for (int d = 12; d < 15; ++d) for (int it = gw; it < 14336; it += NGW) { P0Regs RA; p0_item_load(a.td[d], it, F.lane, RA); p0_item_store(a.td[d], scr, it, F.lane, RA); }
}
__device__ __forceinline__ void rms_row_to_i8(const f32x4 (&v)[4], unsigned char* orow, float* sa, int lane) {
    float s = 0.f, am = 0.f;
#pragma unroll
    for (int j = 0; j < 4; ++j) { s += (v[j].x * v[j].x + v[j].y * v[j].y) + (v[j].z * v[j].z + v[j].w * v[j].w); const f32x4 z = __builtin_elementwise_abs(v[j]); am = fmaxf(am, fmaxf(fmaxf(z.x, z.y), fmaxf(z.z, z.w))); }
    const float rstd = 1.0f / sqrtf(wave_sum(s) * (1.f / DM) + NORM_EPS); am = fmaxf(wave_max(am) * rstd, 1e-30f); const float q = rstd * (127.0f / am);
    unsigned* zo = (unsigned*)orow + lane;
#pragma unroll
    for (int j = 0; j < 4; ++j) zo[64 * j] = pk4_i8(v[j].x * q, v[j].y * q, v[j].z * q, v[j].w * q);
    if (lane == 0) *sa = am * (1.0f / 127.0f);
}
__device__ __forceinline__ void p0_prologue(const Args& a, Frame& F) {
    LAS float* scr = (LAS float*)(F.lds + F.wave * 16384);
    int gw = F.vcu * NWAVES + F.wave, NGW = F.G * NWAVES;
    const bool split = F.G == 256;
#define P0_I8_DISPATCH(cb) do { const int cb_ = (cb); float* sbg_ = (float*)(a.ws + WS_SB); float* sb0_ = (float*)(a.ws + WS_SB0); float* sb1_ = (float*)(a.ws + WS_SB1); \
        if (cb_ < 64) p0_i8_block(a.td[3], F, cb_, sbg_); else if (cb_ < 128) p0_i8_block(a.td[4], F, cb_ - 64, sbg_); else if (cb_ < 152) p0_i8_block(a.td[0], F, cb_ - 128, sb0_); \
        else if (cb_ < 160) p0_i8_block(a.td[6], F, cb_ - 152, sb1_); else if (cb_ < 168) p0_i8_block(a.td[7], F, cb_ - 160, sb1_); else p0_i8_block(a.td[8], F, cb_ - 168, sb1_); } while (0)
    constexpr int NI8 = 175;
    if (split) { if ((int)blockIdx.x < NI8) P0_I8_DISPATCH((int)blockIdx.x); }
    else { for (int cb = (int)blockIdx.x; cb < NI8; cb += F.G) P0_I8_DISPATCH(cb); }
#undef P0_I8_DISPATCH
    const int gw_all = gw, NGW_all = NGW;
    if (split) { gw = ((int)blockIdx.x - 175) * NWAVES + F.wave; NGW = (256 - 175) * NWAVES; }
    if (!split || (int)blockIdx.x >= 175) {
#pragma unroll
    for (int d = 0; d < ND_P0; ++d) { const int lo = a.td[d].item0, hi = a.td[d + 1].item0;

        int it = lo + ((gw - lo) % NGW + NGW) % NGW;
        P0Regs RA, RB;
        if (it < hi) p0_item_load(a.td[d], it - lo, F.lane, RA);
        for (; it < hi; it += 2 * NGW) {
            if (it + NGW < hi) p0_item_load(a.td[d], it + NGW - lo, F.lane, RB);
            p0_item_store(a.td[d], scr, it - lo, F.lane, RA);
            if (it + NGW < hi) { if (it + 2 * NGW < hi) p0_item_load(a.td[d], it + 2 * NGW - lo, F.lane, RA);
                p0_item_store(a.td[d], scr, it + NGW - lo, F.lane, RB); } } }
    }
    gw = gw_all; NGW = NGW_all;
    if (F.G == 256) moe_convert_range(a, F, MQ_SLOTS, MOE_ITEMS, gw, NGW);
    unsigned char* ws = a.ws;
    const int gt = F.vcu * NTHR + F.tid, NGT = F.G * NTHR;
    { v4u z = {0u, 0u, 0u, 0u};
      v4u* p1 = (v4u*)(ws + WS_WIN1 + (size_t)1440 * 1024); for (int i = gt; i < 96 * 1024 / 16; i += NGT) p1[i] = z;
      for (int i = gt; i < 96; i += NGT) ((float*)(ws + WS_SB1))[1440 + i] = 1.0f;
      for (int i = gt; i < 1024 * 16; i += NGT) { const int r = i >> 4, c = i & 15; *(v4u*)(ws + WS_WUKV + (size_t)r * 512 + 256 + c * 16) = z; } }
    { float* cs = (float*)(ws + WS_ROPE);
      for (int i = gt; i < SEQ * 16; i += NGT) { const int t = i >> 4, j = i & 15; const float invf = __builtin_amdgcn_exp2f(-(float)j * (0.0625f * 13.287712379549449f));
          double rev = (double)((float)t * invf) * 0.15915494309189535; rev -= floor(rev); const float rf = (float)rev;
          cs[t * 32 + j] = __builtin_amdgcn_cosf(rf); cs[t * 32 + 16 + j] = __builtin_amdgcn_sinf(rf); } }
    { const float* lre = a.in[3]; const float* lim = a.in[4]; const float* ldt = a.in[5]; const float* bre = a.in[6]; const float* bim = a.in[7]; const float* cre = a.in[8]; const float* cim = a.in[9];
      bf16* BT = (bf16*)(ws + WS_SSM_B); bf16* CT = (bf16*)(ws + WS_SSM_C); float* LM = (float*)(ws + WS_SSM_L);
      for (int i = gt; i < 32 * 64; i += NGT) { const int g = i >> 6, p = i & 63;
          const float dt = __expf(ldt[g]); const float lr = fminf(lre[i], -1e-4f), li = lim[i];
          const float x = lr * dt; const float em1 = x * (1.f + x * (0.5f + x * (0.16666667f + x * (0.041666668f + x * 0.0083333338f))));
          double rev = (double)li * (double)dt * 0.15915494309189535; double revh = 0.5 * rev; rev -= floor(rev); revh -= floor(revh);
          const float co = __builtin_amdgcn_cosf((float)rev), si = __builtin_amdgcn_sinf((float)rev), sh = __builtin_amdgcn_sinf((float)revh);
          const float cm1 = -2.f * sh * sh, mag = 1.f + em1;
          const float lbr = mag * co, lbi = mag * si, nr = em1 * co + cm1, den = lr * lr + li * li;
          const float cr = (nr * lr + lbi * li) / den, ci = (lbi * lr - nr * li) / den;
          double revT = (double)li * (double)dt * (128.0 * 0.15915494309189535); revT -= floor(revT);
          const float magT = __expf(x * 128.f), lTr = magT * __builtin_amdgcn_cosf((float)revT), lTi = magT * __builtin_amdgcn_sinf((float)revT);
          LM[i * 4 + 0] = lbr; LM[i * 4 + 1] = lbi; LM[i * 4 + 2] = lTr; LM[i * 4 + 3] = lTi;
          for (int m = 0; m < 16; ++m) { const float br = bre[(size_t)i * 16 + m], bi = bim[(size_t)i * 16 + m];
              const float bbr = cr * br - ci * bi, bbi = cr * bi + ci * br;
              const unsigned w = pk2(bbr, bbi); BT[((size_t)g * 128 + 2 * p) * 16 + m] = (bf16)(w & 0xffffu); BT[((size_t)g * 128 + 2 * p + 1) * 16 + m] = (bf16)(w >> 16); }
          for (int n = 0; n < 16; ++n) { const float c0 = cre[((size_t)g * 16 + n) * 64 + p], c1 = -cim[((size_t)g * 16 + n) * 64 + p];
              const unsigned w = pk2(c0, c1); CT[((size_t)g * 16 + n) * 128 + 2 * p] = (bf16)(w & 0xffffu); CT[((size_t)g * 16 + n) * 128 + 2 * p + 1] = (bf16)(w >> 16); } } }
    { f32x4 va[4], vb[4]; int m = gw;
#define Z0_LOAD(M, V) do { const f32x4* xr_ = (const f32x4*)(a.in[0] + (size_t)(M) * DM) + F.lane; _Pragma("unroll") for (int j = 0; j < 4; ++j) V[j] = xr_[64 * j]; } while (0)
      if (m < NT) Z0_LOAD(m, va);
      for (; m < NT; m += 2 * NGW) {
          if (m + NGW < NT) Z0_LOAD(m + NGW, vb);
          rms_row_to_i8(va, ws + WS_Z + (size_t)m * DM, (float*)(ws + WS_SA) + m, F.lane);
          if (m + NGW < NT) { if (m + 2 * NGW < NT) Z0_LOAD(m + 2 * NGW, va); rms_row_to_i8(vb, ws + WS_Z + (size_t)(m + NGW) * DM, (float*)(ws + WS_SA) + m + NGW, F.lane); } }
#undef Z0_LOAD
    }
}

template <bool XF32> struct RowIn { f32x4 hf[XF32 ? 4 : 1]; v2u hb[XF32 ? 1 : 4]; v2u mw[4]; };
template <bool XF32>
__device__ __forceinline__ void rn_load(const void* hprev, const bf16* mix, int lane, RowIn<XF32>& R) {
    const v2u* mp = (const v2u*)mix + lane;
#pragma unroll
    for (int j = 0; j < 4; ++j) R.mw[j] = mp[64 * j];
    if (XF32) { const f32x4* xp = (const f32x4*)hprev + lane;
#pragma unroll
        for (int j = 0; j < 4; ++j) R.hf[XF32 ? j : 0] = xp[64 * j];
    } else { const v2u* xp = (const v2u*)hprev + lane;
#pragma unroll
        for (int j = 0; j < 4; ++j) R.hb[XF32 ? 0 : j] = xp[64 * j]; }
}
template <bool XF32, bool Q8 = false>
__device__ __forceinline__ void rn_compute(const RowIn<XF32>& R, const float* gpost, bf16* hout, float* rstd_out, int lane, f32x4 (&hv)[4], float& rstd_h, unsigned char* z8 = nullptr, float* sa_out = nullptr) {
    const f32x4* gp = (const f32x4*)gpost + lane;
    f32x4 mv[4]; float s = 0.f;
#pragma unroll
    for (int j = 0; j < 4; ++j) { const v2u w = R.mw[j]; mv[j] = (f32x4){bf_lo(w.x), bf_hi(w.x), bf_lo(w.y), bf_hi(w.y)}; s += (mv[j].x * mv[j].x + mv[j].y * mv[j].y) + (mv[j].z * mv[j].z + mv[j].w * mv[j].w); }
    f32x4 hp[4];
#pragma unroll
    for (int j = 0; j < 4; ++j) { if (XF32) hp[j] = R.hf[XF32 ? j : 0]; else { const v2u w = R.hb[XF32 ? 0 : j]; hp[j] = (f32x4){bf_lo(w.x), bf_hi(w.x), bf_lo(w.y), bf_hi(w.y)}; } }
    const float rstd = 1.0f / sqrtf(wave_sum(s) * (1.f / DM) + NORM_EPS);
    float s2 = 0.f;
#pragma unroll
    for (int j = 0; j < 4; ++j) { hv[j] = hp[j] + mv[j] * rstd * gp[64 * j]; s2 += (hv[j].x * hv[j].x + hv[j].y * hv[j].y) + (hv[j].z * hv[j].z + hv[j].w * hv[j].w); }
    rstd_h = 1.0f / sqrtf(wave_sum(s2) * (1.f / DM) + NORM_EPS);
    v2u* ho = (v2u*)hout + lane;
#pragma unroll
    for (int j = 0; j < 4; ++j) { v2u w; w.x = pk2(hv[j].x, hv[j].y); w.y = pk2(hv[j].z, hv[j].w); ho[64 * j] = w; }
    if (lane == 0) *rstd_out = rstd_h;
    if (Q8) { float am = 0.f;
#pragma unroll
        for (int j = 0; j < 4; ++j) { const f32x4 z = __builtin_elementwise_abs(hv[j]); am = fmaxf(am, fmaxf(fmaxf(z.x, z.y), fmaxf(z.z, z.w))); }
        am = fmaxf(wave_max(am) * rstd_h, 1e-30f); const float q = rstd_h * (127.0f / am);
        unsigned* zo = (unsigned*)z8 + lane;
#pragma unroll
        for (int j = 0; j < 4; ++j) zo[64 * j] = pk4_i8(hv[j].x * q, hv[j].y * q, hv[j].z * q, hv[j].w * q);
        if (lane == 0) *sa_out = am * (1.0f / 127.0f); }
}
template <bool XF32, bool Q8 = false>
__device__ __forceinline__ void resnorm_phase(const Args& a, Frame& F, const void* hprev, const float* gpost) {
    unsigned char* ws = a.ws; const int gw = F.vcu * NWAVES + F.wave, NGW = F.G * NWAVES;
    const size_t hb = (size_t)DM * (XF32 ? 4 : 2);
#define RN_LOAD(M, R) rn_load<XF32>((const unsigned char*)hprev + (size_t)(M) * hb, (const bf16*)(ws + WS_MIX) + (size_t)(M) * DM, F.lane, R)
#define RN_COMP(M, R) do { f32x4 hv_[4]; float rh_; rn_compute<XF32, Q8>(R, gpost, (bf16*)(ws + WS_H) + (size_t)(M) * DM, (float*)(ws + WS_RSTDQ) + (M), F.lane, hv_, rh_, ws + WS_Z + (size_t)(M) * DM, (float*)(ws + WS_SA) + (M)); } while (0)
    RowIn<XF32> RA, RB; int m = gw;
    if (m < NT) RN_LOAD(m, RA);
    for (; m < NT; m += 2 * NGW) {
        if (m + NGW < NT) RN_LOAD(m + NGW, RB);
        RN_COMP(m, RA);
        if (m + NGW < NT) { if (m + 2 * NGW < NT) RN_LOAD(m + 2 * NGW, RA); RN_COMP(m + NGW, RB); } }
#undef RN_LOAD
#undef RN_COMP
}

__device__ __forceinline__ float dpp_swap1(float v) { return __builtin_bit_cast(float, __builtin_amdgcn_update_dpp(0, __builtin_bit_cast(int, v), 0xB1, 0xF, 0xF, true)); }
typedef short v4i16_t __attribute__((ext_vector_type(4)));
__device__ __forceinline__ f32x4 mfma16(bf16x8 a, bf16x8 b, f32x4 c) { return __builtin_amdgcn_mfma_f32_16x16x32_bf16(a, b, c, 0, 0, 0); }
constexpr int SSM_CH = 128;
__device__ __forceinline__ void ssm_block(const Args& a, Frame& F, int blk) {
    const int b = blk >> 5, g = blk & 31, lane = F.lane, w = F.wave, c = lane & 15, q = lane >> 4;
    unsigned char* ws = a.ws;
    const bf16* U = (const bf16*)(ws + WS_USSM); bf16* YB = (bf16*)(ws + WS_YB);
    const bf16* BT = (const bf16*)(ws + WS_SSM_B) + (size_t)g * 128 * 16;
    const bf16* CT = (const bf16*)(ws + WS_SSM_C) + (size_t)g * 16 * 128;
    const float* LM = (const float*)(ws + WS_SSM_L) + (size_t)g * 64 * 4;
    LAS float* S = (LAS float*)F.lds;
    LAS float* Gb = (LAS float*)(F.lds + 16384);
    LAS bf16* Hst = (LAS bf16*)(F.lds + 32768 + w * 4096);
    const bf16x8 zero8 = {0, 0, 0, 0, 0, 0, 0, 0};
    bf16x8 bfr[8]; float cr[8], cs[8];
#pragma unroll
    for (int j = 0; j < 8; ++j) { bfr[j] = (q < 2) ? *(const bf16x8*)(BT + (16 * j + c) * 16 + 8 * q) : zero8;
        const int p = 8 * j + (c >> 1); cr[j] = LM[p * 4 + 0]; const float li = LM[p * 4 + 1]; cs[j] = (c & 1) ? li : -li; }
    bf16x8 cfr[4];
#pragma unroll
    for (int s2 = 0; s2 < 4; ++s2) cfr[s2] = *(const bf16x8*)(CT + c * 128 + 32 * s2 + 8 * q);
    const float dval = a.in[10][g * 16 + c];
    const int qa = c >> 2, ra = c & 3;
    const bf16* ua = U + ((size_t)b * SEQ + (size_t)(4 * w + qa) * SSM_CH + ra) * 512 + g * 16 + 8 * (q & 1);
    const f32x4 z4 = {0.f, 0.f, 0.f, 0.f};
    float xp[8];
#pragma unroll
    for (int j = 0; j < 8; ++j) xp[j] = 0.f;
    bf16x8 afq[4];
#pragma unroll
    for (int u = 0; u < 4; ++u) { afq[u] = zero8; if (q < 2) afq[u] = *(const bf16x8*)(ua + (size_t)u * 4 * 512); }
    for (int s4 = 0; s4 < SSM_CH / 16; ++s4) {
#pragma unroll
        for (int u = 0; u < 4; ++u) { const int s = 4 * s4 + u; const bf16x8 af = afq[u];
            if (q < 2 && s + 4 < SSM_CH / 4) afq[u] = *(const bf16x8*)(ua + (size_t)(s + 4) * 4 * 512);
#pragma unroll
            for (int j = 0; j < 8; ++j) { const f32x4 d = mfma16(af, bfr[j], z4);
                float x = xp[j];
#pragma unroll
                for (int r = 0; r < 4; ++r) x = d[r] + cr[j] * x + cs[j] * dpp_swap1(x);
                xp[j] = x; } }
    }
#pragma unroll
    for (int j = 0; j < 8; ++j) S[(4 * w + q) * 128 + 16 * j + c] = xp[j];
    __syncthreads();
    if (w == 0) { const int p = lane; const float lTr = LM[p * 4 + 2], lTi = LM[p * 4 + 3]; float gr = 0.f, gi = 0.f;
        for (int k = 0; k < 32; ++k) { Gb[k * 128 + 2 * p] = gr; Gb[k * 128 + 2 * p + 1] = gi; const float sr = S[k * 128 + 2 * p], si = S[k * 128 + 2 * p + 1];
            const float nr = lTr * gr - lTi * gi + sr, ni = lTr * gi + lTi * gr + si; gr = nr; gi = ni; } }
    __syncthreads();
#pragma unroll
    for (int j = 0; j < 8; ++j) xp[j] = Gb[(4 * w + q) * 128 + 16 * j + c];
    const size_t tok0 = (size_t)b * SEQ + (size_t)(4 * w + q) * SSM_CH;
    const bf16* ud = U + tok0 * 512 + g * 16 + c;
    float uq[4][4];
#pragma unroll
    for (int u = 0; u < 4; ++u) { afq[u] = zero8; if (q < 2) afq[u] = *(const bf16x8*)(ua + (size_t)u * 4 * 512);
#pragma unroll
        for (int r = 0; r < 4; ++r) uq[u][r] = bf_lo((unsigned)ud[(size_t)(4 * u + r) * 512]); }
    for (int s4 = 0; s4 < SSM_CH / 16; ++s4) {
#pragma unroll
      for (int u = 0; u < 4; ++u) { const int s = 4 * s4 + u; const bf16x8 af = afq[u]; float uv[4];
#pragma unroll
        for (int r = 0; r < 4; ++r) uv[r] = uq[u][r];
        if (s + 4 < SSM_CH / 4) { if (q < 2) afq[u] = *(const bf16x8*)(ua + (size_t)(s + 4) * 4 * 512);
#pragma unroll
            for (int r = 0; r < 4; ++r) uq[u][r] = bf_lo((unsigned)ud[(size_t)(4 * (s + 4) + r) * 512]); }
#pragma unroll
        for (int j = 0; j < 8; ++j) { const f32x4 d = mfma16(af, bfr[j], z4);
            float x = xp[j]; float xs[4];
#pragma unroll
            for (int r = 0; r < 4; ++r) { x = d[r] + cr[j] * x + cs[j] * dpp_swap1(x); xs[r] = x; }
            xp[j] = x;
            v2u hw; hw.x = pk2(xs[0], xs[1]); hw.y = pk2(xs[2], xs[3]);
            *(LAS v2u*)(Hst + (16 * j + c) * 16 + 4 * q) = hw; }
        f32x4 y = z4;
#pragma unroll
        for (int s2 = 0; s2 < 4; ++s2) { const LAS unsigned char* hp = (const LAS unsigned char*)Hst + (32 * s2 + 8 * q + ((lane & 15) >> 2)) * 32 + (lane & 3) * 8;
            const v4i16_t lo = __builtin_amdgcn_ds_read_tr16_b64_v4i16((LAS v4i16_t*)hp), hi = __builtin_amdgcn_ds_read_tr16_b64_v4i16((LAS v4i16_t*)(hp + 128));
            const bf16x8 hf = {lo[0], lo[1], lo[2], lo[3], hi[0], hi[1], hi[2], hi[3]}; y = mfma16(hf, cfr[s2], y); }
#pragma unroll
        for (int r = 0; r < 4; ++r) { const size_t o = (tok0 + 4 * s + r) * 512 + g * 16 + c; const float v = y[r] + dval * uv[r];
            YB[o] = (bf16)(pk2(gelu_f(v), 0.f) & 0xffffu); } }
    }
}
__device__ __forceinline__ void sgu_block(const Args& a, Frame& F, int item) {
    const int b = item >> 5, ck = item & 31, lane = F.lane, h = F.wave, c = lane & 15, q = lane >> 4;
    unsigned char* ws = a.ws; const size_t T0 = (size_t)b * SEQ + (size_t)ck * 128;
    const bf16* GV = (const bf16*)(ws + WS_GV); const bf16* GU = (const bf16*)(ws + WS_GU); bf16* MC = (bf16*)(ws + WS_MIXCAT0);
    LAS bf16* Vt = (LAS bf16*)F.lds;
    LAS float* part = (LAS float*)(F.lds + 139264);
    { const int s = F.tid & 127, cq = F.tid >> 7; const v4u* src = (const v4u*)(GV + (T0 + s) * 512 + cq * 128);
      float sum = 0.f, sq = 0.f;
#pragma unroll 4
      for (int i = 0; i < 16; ++i) { const v4u xv = src[i];
          const float f0 = bf_lo(xv.x), f1 = bf_hi(xv.x), f2 = bf_lo(xv.y), f3 = bf_hi(xv.y), f4 = bf_lo(xv.z), f5 = bf_hi(xv.z), f6 = bf_lo(xv.w), f7 = bf_hi(xv.w);
          sum += ((f0 + f1) + (f2 + f3)) + ((f4 + f5) + (f6 + f7)); sq += ((f0 * f0 + f1 * f1) + (f2 * f2 + f3 * f3)) + ((f4 * f4 + f5 * f5) + (f6 * f6 + f7 * f7)); }
      part[(cq * 128 + s) * 2] = sum; part[(cq * 128 + s) * 2 + 1] = sq;
      __syncthreads();
      float ts = 0.f, tq = 0.f;
#pragma unroll
      for (int k = 0; k < 4; ++k) { ts += part[(k * 128 + s) * 2]; tq += part[(k * 128 + s) * 2 + 1]; }
      const float mean = ts * (1.f / 512.f), var = fmaxf(tq * (1.f / 512.f) - mean * mean, 0.f), rstd = 1.0f / sqrtf(var + NORM_EPS);
      const float* lng = a.in[12] + cq * 128; const float* lnb = a.in[13] + cq * 128;
#pragma unroll 2
      for (int i = 0; i < 16; ++i) { const v4u xv = src[i]; const f32x4 g0 = *(const f32x4*)(lng + 8 * i), g1 = *(const f32x4*)(lng + 8 * i + 4), b0 = *(const f32x4*)(lnb + 8 * i), b1 = *(const f32x4*)(lnb + 8 * i + 4);
          LAS bf16* vp = Vt + (cq * 128 + 8 * i) * 136 + s;
          const unsigned p0 = pk2((bf_lo(xv.x) - mean) * rstd * g0.x + b0.x, (bf_hi(xv.x) - mean) * rstd * g0.y + b0.y), p1 = pk2((bf_lo(xv.y) - mean) * rstd * g0.z + b0.z, (bf_hi(xv.y) - mean) * rstd * g0.w + b0.w);
          const unsigned p2 = pk2((bf_lo(xv.z) - mean) * rstd * g1.x + b1.x, (bf_hi(xv.z) - mean) * rstd * g1.y + b1.y), p3 = pk2((bf_lo(xv.w) - mean) * rstd * g1.z + b1.z, (bf_hi(xv.w) - mean) * rstd * g1.w + b1.w);
          vp[0 * 136] = (bf16)(p0 & 0xffffu); vp[1 * 136] = (bf16)(p0 >> 16); vp[2 * 136] = (bf16)(p1 & 0xffffu); vp[3 * 136] = (bf16)(p1 >> 16);
          vp[4 * 136] = (bf16)(p2 & 0xffffu); vp[5 * 136] = (bf16)(p2 >> 16); vp[6 * 136] = (bf16)(p3 & 0xffffu); vp[7 * 136] = (bf16)(p3 >> 16); }
    }
    __syncthreads();
    const float* Wh = a.in[14] + (size_t)h * 128 * 128; const float* bs = a.in[15] + h * 128;
    const f32x4 z4 = {0.f, 0.f, 0.f, 0.f};
    for (int mt = 0; mt < 8; ++mt) {
        f32x4 acc[4] = {z4, z4, z4, z4}; const int t = 16 * mt + c; const int nks = (16 * mt + 15) / 32 + 1;
        f32x4 wl[4][2];
#pragma unroll
        for (int ks = 0; ks < 4; ++ks) if (ks < nks) { const float* wp = Wh + (size_t)t * 128 + 32 * ks + 8 * q; wl[ks][0] = *(const f32x4*)wp; wl[ks][1] = *(const f32x4*)(wp + 4); }
        float uu[4][4];
#pragma unroll
        for (int nt = 0; nt < 4; ++nt)
#pragma unroll
            for (int r = 0; r < 4; ++r) uu[nt][r] = bf_lo((unsigned)GU[(T0 + 16 * mt + 4 * q + r) * 512 + h * 64 + 16 * nt + c]);
#pragma unroll
        for (int ks = 0; ks < 4; ++ks) if (ks < nks) { const int s0 = 32 * ks + 8 * q; const f32x4 w0 = wl[ks][0], w1 = wl[ks][1];
            const int lim = t - s0;
            v4u ap; ap.x = pk2(lim >= 0 ? w0.x : 0.f, lim >= 1 ? w0.y : 0.f); ap.y = pk2(lim >= 2 ? w0.z : 0.f, lim >= 3 ? w0.w : 0.f); ap.z = pk2(lim >= 4 ? w1.x : 0.f, lim >= 5 ? w1.y : 0.f); ap.w = pk2(lim >= 6 ? w1.z : 0.f, lim >= 7 ? w1.w : 0.f);
            const bf16x8 af = __builtin_bit_cast(bf16x8, ap);
#pragma unroll
            for (int nt = 0; nt < 4; ++nt) { const bf16x8 bf = *(const LAS bf16x8*)(Vt + (h * 64 + 16 * nt + c) * 136 + s0); acc[nt] = mfma16(af, bf, acc[nt]); } }
#pragma unroll
        for (int nt = 0; nt < 4; ++nt)
#pragma unroll
            for (int r = 0; r < 4; ++r) { const int tt = 16 * mt + 4 * q + r, ch = h * 64 + 16 * nt + c; const float sv = acc[nt][r] + bs[tt];
                MC[(T0 + tt) * 1024 + 512 + ch] = (bf16)(pk2(uu[nt][r] * sv, 0.f) & 0xffffu); }
    }
    __syncthreads();
}

__device__ __forceinline__ void conv_prep_phase(const Args& a, Frame& F) {
    unsigned char* ws = a.ws; const bf16* HG = (const bf16*)(ws + WS_HGLU); bf16* MC = (bf16*)(ws + WS_MIXCAT1);
    LAS bf16* Xin = (LAS bf16*)F.lds;
    LAS float* Co = (LAS float*)(F.lds + 63488);
    const int tid = F.tid, lane = F.lane, w = F.wave;
    const float* cw = a.in[21]; const float* cb = a.in[22]; const float* lg = a.in[23]; const float* lb = a.in[24];
    for (int item = (int)blockIdx.x; item < NT / 32; item += F.G) {
        const int t0 = item * 32, tl0 = t0 & (SEQ - 1);
        for (int i = tid; i < 62 * 64; i += NTHR) { const int r = i >> 6, cc = i & 63; const int tl = tl0 - 30 + r; v4u v = {0u, 0u, 0u, 0u};
            if (tl >= 0) v = *(const v4u*)(HG + (size_t)(t0 - 30 + r) * 512 + cc * 8);
            *(LAS v4u*)(Xin + r * 512 + cc * 8) = v; }
        __syncthreads();
        { const int ch = tid; float wk[31];
#pragma unroll
          for (int k = 0; k < 31; ++k) wk[k] = cw[k * 512 + ch];
          const float bias = cb[ch];
#pragma unroll
          for (int hf = 0; hf < 2; ++hf) { float xin[46];
#pragma unroll
              for (int i = 0; i < 46; ++i) xin[i] = bf_lo((unsigned)Xin[(16 * hf + i) * 512 + ch]);
#pragma unroll
              for (int tt = 0; tt < 16; ++tt) { float acc = bias;
#pragma unroll
                  for (int k = 0; k < 31; ++k) acc += wk[k] * xin[tt + k];
                  Co[(16 * hf + tt) * 512 + ch] = acc; } } }
        __syncthreads();
#pragma unroll
        for (int i = 0; i < 4; ++i) { const int tt = 4 * w + i; const LAS float* row = Co + tt * 512;
            const f32x4 x0 = *(const LAS f32x4*)(row + 4 * lane), x1 = *(const LAS f32x4*)(row + 256 + 4 * lane);
            const float mean = wave_sum((x0.x + x0.y) + (x0.z + x0.w) + (x1.x + x1.y) + (x1.z + x1.w)) * (1.f / 512.f);
            const f32x4 d0 = x0 - mean, d1 = x1 - mean;
            const float var = wave_sum((d0.x * d0.x + d0.y * d0.y) + (d0.z * d0.z + d0.w * d0.w) + (d1.x * d1.x + d1.y * d1.y) + (d1.z * d1.z + d1.w * d1.w)) * (1.f / 512.f);
            const float rstd = 1.0f / sqrtf(var + NORM_EPS);
            const f32x4 g0 = *(const f32x4*)(lg + 4 * lane), g1 = *(const f32x4*)(lg + 256 + 4 * lane), b0 = *(const f32x4*)(lb + 4 * lane), b1 = *(const f32x4*)(lb + 256 + 4 * lane);
            const f32x4 y0 = d0 * rstd * g0 + b0, y1 = d1 * rstd * g1 + b1;
            v2u o0, o1; o0.x = pk2(silu_f(y0.x), silu_f(y0.y)); o0.y = pk2(silu_f(y0.z), silu_f(y0.w)); o1.x = pk2(silu_f(y1.x), silu_f(y1.y)); o1.y = pk2(silu_f(y1.z), silu_f(y1.w));
            bf16* op = MC + (size_t)(t0 + tt) * 1024; *(v2u*)(op + 4 * lane) = o0; *(v2u*)(op + 256 + 4 * lane) = o1; }
        __syncthreads();
    }
    bf16* CQ = (bf16*)(ws + WS_CQ); bf16* CKV = (bf16*)(ws + WS_CKV); bf16* KK = (bf16*)(ws + WS_KK);
    const float* cs = (const float*)(ws + WS_ROPE);
    const int gw = F.vcu * NWAVES + w, NGW = F.G * NWAVES;
    for (int tok0 = gw * 4; tok0 < NT; tok0 += NGW * 4) {
        v2u qv[4]; unsigned kv[4]; unsigned short r1[4], r2[4]; float co[4], si[4];
        const int i = lane & 15, hh = lane >> 4;
#pragma unroll
        for (int u = 0; u < 4; ++u) { const int tok = tok0 + u; qv[u] = *((const v2u*)(CQ + (size_t)tok * 256) + lane); kv[u] = *((const unsigned*)(CKV + (size_t)tok * 256) + lane);
            r1[u] = CKV[(size_t)tok * 256 + 128 + i]; r2[u] = CKV[(size_t)tok * 256 + 144 + i];
            co[u] = cs[(size_t)(tok & (SEQ - 1)) * 32 + i]; si[u] = cs[(size_t)(tok & (SEQ - 1)) * 32 + 16 + i]; }
#pragma unroll
        for (int u = 0; u < 4; ++u) { const int tok = tok0 + u;
            const float q0 = bf_lo(qv[u].x), q1 = bf_hi(qv[u].x), q2 = bf_lo(qv[u].y), q3 = bf_hi(qv[u].y), k0 = bf_lo(kv[u]), k1 = bf_hi(kv[u]);
            const float sq = wave_sum((q0 * q0 + q1 * q1) + (q2 * q2 + q3 * q3)), sk = wave_sum(k0 * k0 + k1 * k1);
            const float rsq = 1.0f / sqrtf(sq * (1.f / 256.f) + NORM_EPS), rsk = 1.0f / sqrtf(sk * (1.f / 128.f) + NORM_EPS);
            v2u qo; qo.x = pk2(q0 * rsq, q1 * rsq); qo.y = pk2(q2 * rsq, q3 * rsq); *((v2u*)(CQ + (size_t)tok * 256) + lane) = qo; *((unsigned*)(CKV + (size_t)tok * 256) + lane) = pk2(k0 * rsk, k1 * rsk);
            const float x1 = bf_lo((unsigned)r1[u]), x2 = bf_lo((unsigned)r2[u]);
            const unsigned pw = pk2(x1 * co[u] - x2 * si[u], x2 * co[u] + x1 * si[u]);
            bf16* kp = KK + (size_t)tok * 768 + 64 + i;
            kp[hh * 96] = (bf16)(pw & 0xffffu); kp[hh * 96 + 16] = (bf16)(pw >> 16); kp[(hh + 4) * 96] = (bf16)(pw & 0xffffu); kp[(hh + 4) * 96 + 16] = (bf16)(pw >> 16); }
    }
}

#ifndef ATT_PROBE
#define ATT_PROBE 0
#endif
typedef float f32x16 __attribute__((ext_vector_type(16)));
__device__ __forceinline__ f32x16 mfma32(bf16x8 a, bf16x8 b, f32x16 c) { return __builtin_amdgcn_mfma_f32_32x32x16_bf16(a, b, c, 0, 0, 0); }
__device__ __forceinline__ v4i16_t tr_read(const LAS unsigned char* p) { return __builtin_amdgcn_ds_read_tr16_b64_v4i16((LAS v4i16_t*)p); }
constexpr int AT_KP = 208, AT_VP = 144, AT_KB = 64 * AT_KP, AT_VB = 64 * AT_VP;
__device__ __forceinline__ void attn_tile_A(const LAS unsigned char* kb, const bf16x8 (&qr)[6], f32x16& p0, f32x16& p1, int kt, int q0, int r32, int hi) {
#pragma unroll
    for (int r = 0; r < 16; ++r) { p0[r] = 0.f; p1[r] = 0.f; }
    bf16x8 kf[12];
#pragma unroll
    for (int ds = 0; ds < 3; ++ds) { kf[2 * ds] = *(const LAS bf16x8*)(kb + r32 * AT_KP + ds * 32 + hi * 16); kf[2 * ds + 1] = *(const LAS bf16x8*)(kb + (32 + r32) * AT_KP + ds * 32 + hi * 16); }
    __builtin_amdgcn_sched_barrier(0);
#pragma unroll
    for (int ds = 3; ds < 6; ++ds) { kf[2 * ds] = *(const LAS bf16x8*)(kb + r32 * AT_KP + ds * 32 + hi * 16); kf[2 * ds + 1] = *(const LAS bf16x8*)(kb + (32 + r32) * AT_KP + ds * 32 + hi * 16); }
#pragma unroll
    for (int ds = 0; ds < 3; ++ds) { p0 = mfma32(kf[2 * ds], qr[ds], p0); p1 = mfma32(kf[2 * ds + 1], qr[ds], p1); }
    __builtin_amdgcn_sched_barrier(0);
#pragma unroll
    for (int ds = 3; ds < 6; ++ds) { p0 = mfma32(kf[2 * ds], qr[ds], p0); p1 = mfma32(kf[2 * ds + 1], qr[ds], p1); }
    if (kt * 64 + 63 > q0) { const int qg = q0 + r32;
#pragma unroll
        for (int r = 0; r < 16; ++r) { const int key = kt * 64 + (r & 3) + 8 * (r >> 2) + 4 * hi; if (key > qg) p0[r] = -INFINITY; if (key + 32 > qg) p1[r] = -INFINITY; } }
}
__device__ __forceinline__ void attn_tile_B(const LAS unsigned char* vb, f32x16& p0, f32x16& p1, f32x16& o0, f32x16& o1, float& m, float& l, int kt) {
    v4i16_t vlo[8], vhi[8];
#pragma unroll
    for (int s = 0; s < 4; ++s)
#pragma unroll
        for (int db = 0; db < 2; ++db) { vlo[2 * s + db] = tr_read(vb + (16 * s) * AT_VP + db * 64); vhi[2 * s + db] = tr_read(vb + (16 * s + 8) * AT_VP + db * 64); }
    __builtin_amdgcn_sched_barrier(0);
    if (__any(m != 0.f)) {
#pragma unroll
        for (int r = 0; r < 16; ++r) { p0[r] -= m; p1[r] -= m; } }
    float ma = fmaxf(fmaxf(p0[0], p0[1]), p1[0]), mb = fmaxf(fmaxf(p0[2], p0[3]), p1[1]);
    ma = fmaxf(fmaxf(ma, p1[2]), p1[3]);
#pragma unroll
    for (int r = 4; r < 16; r += 4) { ma = fmaxf(fmaxf(ma, p0[r]), p0[r + 1]); mb = fmaxf(fmaxf(mb, p0[r + 2]), p0[r + 3]); ma = fmaxf(fmaxf(ma, p1[r]), p1[r + 1]); mb = fmaxf(fmaxf(mb, p1[r + 2]), p1[r + 3]); }
    float mt = fmaxf(ma, mb); { const auto rr = __builtin_amdgcn_permlane32_swap(__float_as_uint(mt), __float_as_uint(mt), false, false); mt = fmaxf(__uint_as_float(rr[0]), __uint_as_float(rr[1])); }
    if (__any(mt > 8.0f || (kt == 0 && mt < -24.0f))) {
        const float dl = mt > 8.0f ? mt : ((kt == 0 && mt < -24.0f) ? mt : 0.f); m += dl; const float alpha = __builtin_amdgcn_exp2f(-dl); l *= alpha;
#pragma unroll
        for (int r = 0; r < 16; ++r) { p0[r] -= dl; p1[r] -= dl; o0[r] *= alpha; o1[r] *= alpha; } }
    float ps = 0.f;
#pragma unroll
    for (int r = 0; r < 16; ++r) { p0[r] = __builtin_amdgcn_exp2f(p0[r]); p1[r] = __builtin_amdgcn_exp2f(p1[r]); ps += p0[r] + p1[r]; }
    l += ps;
#if ATT_PROBE == 2
    { float qs = 0.f;
#pragma unroll
      for (int r = 0; r < 16; ++r) { qs += __builtin_amdgcn_exp2f(p0[r] - 1.0f) + __builtin_amdgcn_exp2f(p1[r] - 1.0f); }
      l += 0.f * qs; }
#endif
    v4u w0, w1, w2, w3;
    w0.x = pk2(p0[0], p0[1]); w0.y = pk2(p0[2], p0[3]); w0.z = pk2(p0[4], p0[5]); w0.w = pk2(p0[6], p0[7]);
    w1.x = pk2(p0[8], p0[9]); w1.y = pk2(p0[10], p0[11]); w1.z = pk2(p0[12], p0[13]); w1.w = pk2(p0[14], p0[15]);
    w2.x = pk2(p1[0], p1[1]); w2.y = pk2(p1[2], p1[3]); w2.z = pk2(p1[4], p1[5]); w2.w = pk2(p1[6], p1[7]);
    w3.x = pk2(p1[8], p1[9]); w3.y = pk2(p1[10], p1[11]); w3.z = pk2(p1[12], p1[13]); w3.w = pk2(p1[14], p1[15]);
    const bf16x8 pa0 = __builtin_bit_cast(bf16x8, w0), pa1 = __builtin_bit_cast(bf16x8, w1), pa2 = __builtin_bit_cast(bf16x8, w2), pa3 = __builtin_bit_cast(bf16x8, w3);
#define AT_VF(s, db) ((bf16x8){vlo[2 * (s) + (db)][0], vlo[2 * (s) + (db)][1], vlo[2 * (s) + (db)][2], vlo[2 * (s) + (db)][3], vhi[2 * (s) + (db)][0], vhi[2 * (s) + (db)][1], vhi[2 * (s) + (db)][2], vhi[2 * (s) + (db)][3]})
    o0 = mfma32(AT_VF(0, 0), pa0, o0); o1 = mfma32(AT_VF(0, 1), pa0, o1);
    o0 = mfma32(AT_VF(1, 0), pa1, o0); o1 = mfma32(AT_VF(1, 1), pa1, o1);
    o0 = mfma32(AT_VF(2, 0), pa2, o0); o1 = mfma32(AT_VF(2, 1), pa2, o1);
    o0 = mfma32(AT_VF(3, 0), pa3, o0); o1 = mfma32(AT_VF(3, 1), pa3, o1);
#if ATT_PROBE == 3
    { f32x16 e0, e1;
#pragma unroll
      for (int r = 0; r < 16; ++r) { e0[r] = 0.f; e1[r] = 0.f; }
      e0 = mfma32(AT_VF(0, 0), pa0, e0); e1 = mfma32(AT_VF(0, 1), pa0, e1); e0 = mfma32(AT_VF(1, 0), pa1, e0); e1 = mfma32(AT_VF(1, 1), pa1, e1);
      e0 = mfma32(AT_VF(2, 0), pa2, e0); e1 = mfma32(AT_VF(2, 1), pa2, e1); e0 = mfma32(AT_VF(3, 0), pa3, e0); e1 = mfma32(AT_VF(3, 1), pa3, e1);
#pragma unroll
      for (int r = 0; r < 16; ++r) { o0[r] += 0.f * e0[r]; o1[r] += 0.f * e1[r]; } }
#endif
#undef AT_VF
}
constexpr int AT_STG = 2 * AT_KB + 2 * AT_VB;
__device__ __forceinline__ void attn_unit(const Args& a, Frame& F, int bh, int qblk) {
    unsigned char* ws = a.ws;
    const int b = bh >> 3, h = bh & 7, lane = F.lane, w = F.wave, r32 = lane & 31, hi = lane >> 5, tid = F.tid;
    const bf16* Q = (const bf16*)(ws + WS_Q); const bf16* KK = (const bf16*)(ws + WS_KK); const bf16* VV = (const bf16*)(ws + WS_VV); bf16* O = (bf16*)(ws + WS_MIXCAT1);
    LAS unsigned char* Sb = F.lds; LAS bf16* Ost = (LAS bf16*)(F.lds + 2 * AT_STG + w * 4096);
    const size_t tokb = (size_t)b * SEQ; const int q0 = qblk * 256 + 32 * w;
    bf16x8 qr[6];
    { const bf16* qp = Q + (tokb + q0 + r32) * 768 + h * 96 + 8 * hi;
#pragma unroll
      for (int ds = 0; ds < 6; ++ds) qr[ds] = *(const bf16x8*)(qp + 16 * ds); }
    f32x16 o0, o1, p0, p1, p2, p3;
#pragma unroll
    for (int r = 0; r < 16; ++r) { o0[r] = 0.f; o1[r] = 0.f; }
    float m = 0.f, l = 0.f;
    const int NST = 2 * qblk + 2, ktmax = (q0 + 31) >> 6;
    const bf16* kg[3]; int kl[3]; const bf16* vg[2]; int vl[2];
#pragma unroll
    for (int i = 0; i < 3; ++i) { const int c = tid + 512 * i, tl = c / 768, cc = c - tl * 768, row = cc / 12, col = cc - row * 12; kg[i] = KK + (tokb + tl * 64 + row) * 768 + h * 96 + col * 8; kl[i] = tl * AT_KB + row * AT_KP + col * 16; }
#pragma unroll
    for (int i = 0; i < 2; ++i) { const int v = tid + 512 * i, tl = v >> 9, row = (v & 511) >> 3, col = v & 7; vg[i] = VV + (tokb + tl * 64 + row) * 512 + h * 64 + col * 8; vl[i] = 2 * AT_KB + tl * AT_VB + row * AT_VP + col * 16; }
    v4u rk[3], rv[2];
#define AT_LOAD(ST) do { const int st_ = (ST) < NST ? (ST) : NST - 1; const size_t adv_ = (size_t)st_ * 128; _Pragma("unroll") for (int i = 0; i < 3; ++i) rk[i] = *(const v4u*)(kg[i] + adv_ * 768); _Pragma("unroll") for (int i = 0; i < 2; ++i) rv[i] = *(const v4u*)(vg[i] + adv_ * 512); } while (0)
#define AT_STORE(BUF) do { LAS unsigned char* sb_ = Sb + (BUF) * AT_STG; _Pragma("unroll") for (int i = 0; i < 3; ++i) *(LAS v4u*)(sb_ + kl[i]) = rk[i]; _Pragma("unroll") for (int i = 0; i < 2; ++i) *(LAS v4u*)(sb_ + vl[i]) = rv[i]; } while (0)
#define AT_BAR() do { asm volatile("s_waitcnt lgkmcnt(0)" ::: "memory"); __builtin_amdgcn_s_barrier(); asm volatile("" ::: "memory"); } while (0)
    AT_LOAD(0); AT_STORE(0); AT_BAR(); AT_LOAD(1);
    const int vlane = (4 * hi + ((lane & 15) >> 2)) * AT_VP + ((lane >> 4) & 1) * 32 + (lane & 3) * 8;
    for (int st = 0; st < NST; ++st) {
        const LAS unsigned char* sb = Sb + (st & 1) * AT_STG;
        if (2 * st + 1 <= ktmax) {
            attn_tile_A(sb, qr, p0, p1, 2 * st, q0, r32, hi);
            attn_tile_A(sb + AT_KB, qr, p2, p3, 2 * st + 1, q0, r32, hi);
            attn_tile_B(sb + 2 * AT_KB + vlane, p0, p1, o0, o1, m, l, 2 * st);
            attn_tile_B(sb + 2 * AT_KB + AT_VB + vlane, p2, p3, o0, o1, m, l, 2 * st + 1);
        } else if (2 * st <= ktmax) { attn_tile_A(sb, qr, p0, p1, 2 * st, q0, r32, hi); attn_tile_B(sb + 2 * AT_KB + vlane, p0, p1, o0, o1, m, l, 2 * st); }
        if (st + 1 < NST) AT_STORE((st + 1) & 1);
        AT_BAR();
        AT_LOAD(st + 2);
    }
#undef AT_LOAD
#undef AT_STORE
#undef AT_BAR
    l += __shfl_xor(l, 32);
    const float inv = 1.0f / l;
#pragma unroll
    for (int r = 0; r < 16; ++r) { const int d = (r & 3) + 8 * (r >> 2) + 4 * hi; const unsigned pw = pk2(o0[r] * inv, o1[r] * inv);
        Ost[r32 * 64 + d] = (bf16)(pw & 0xffffu); Ost[r32 * 64 + 32 + d] = (bf16)(pw >> 16); }
#pragma unroll
    for (int i = 0; i < 4; ++i) { const int id = i * 64 + lane, row = id >> 3, cc = id & 7; const v4u v = *(const LAS v4u*)(Ost + row * 64 + cc * 8);
        *(v4u*)(O + (tokb + q0 + row) * 1024 + 512 + h * 64 + cc * 8) = v; }
    __syncthreads();
}
__device__ __forceinline__ void attn_phase(const Args& a, Frame& F) {
    for (int u = (int)blockIdx.x; u < 512; u += F.G) { const int v = u & 255, bh = v >> 3, s = v & 7; attn_unit(a, F, bh, u < 256 ? s : 15 - s); }
}

__device__ __forceinline__ void resnorm_router_phase(const Args& a, Frame& F, const float* gpost, const float* gpre) {
    unsigned char* ws = a.ws; const int lane = F.lane, w = F.wave, tid = F.tid;
    LAS int* cnt = (LAS int*)F.lds;
    const float* wr = a.in[30]; int* tok_e = (int*)(ws + WS_TOKE); float* tok_w = (float*)(ws + WS_TOKW); int* bcnt = (int*)(ws + WS_BCNT);
    for (int grp = (int)blockIdx.x; grp < NT / 64; grp += F.G) {
        if (tid < 8) cnt[tid] = 0;
        __syncthreads();
        RowIn<false> RI[2];
        rn_load<false>((const bf16*)(ws + WS_H) + (size_t)(grp * 64 + w * 8) * DM, (const bf16*)(ws + WS_MIX) + (size_t)(grp * 64 + w * 8) * DM, lane, RI[0]);
#pragma unroll
        for (int i = 0; i < 8; ++i) { const int tok = grp * 64 + w * 8 + i; f32x4 hv[4]; float rh;
            if (i < 7) rn_load<false>((const bf16*)(ws + WS_H) + (size_t)(tok + 1) * DM, (const bf16*)(ws + WS_MIX) + (size_t)(tok + 1) * DM, lane, RI[(i + 1) & 1]);
            rn_compute<false>(RI[i & 1], gpost, (bf16*)(ws + WS_H) + (size_t)tok * DM, (float*)(ws + WS_RSTDQ) + tok, lane, hv, rh);
            float l0 = 0.f, l1 = 0.f, l2 = 0.f, l3 = 0.f, l4 = 0.f, l5 = 0.f, l6 = 0.f, l7 = 0.f;
#pragma unroll
            for (int j = 0; j < 4; ++j) { const int k0 = 256 * j + 4 * lane; const f32x4 g = *(const f32x4*)(gpre + k0); const f32x4 z = hv[j] * rh * g;
#pragma unroll
                for (int c = 0; c < 4; ++c) { const f32x4 wa = *(const f32x4*)(wr + (size_t)(k0 + c) * 8), wb = *(const f32x4*)(wr + (size_t)(k0 + c) * 8 + 4); const float zc = z[c];
                    l0 += zc * wa.x; l1 += zc * wa.y; l2 += zc * wa.z; l3 += zc * wa.w; l4 += zc * wb.x; l5 += zc * wb.y; l6 += zc * wb.z; l7 += zc * wb.w; } }
            l0 = wave_sum(l0); l1 = wave_sum(l1); l2 = wave_sum(l2); l3 = wave_sum(l3); l4 = wave_sum(l4); l5 = wave_sum(l5); l6 = wave_sum(l6); l7 = wave_sum(l7);
            int i0 = 0; float v0 = l0;
            if (l1 > v0) { v0 = l1; i0 = 1; } if (l2 > v0) { v0 = l2; i0 = 2; } if (l3 > v0) { v0 = l3; i0 = 3; } if (l4 > v0) { v0 = l4; i0 = 4; } if (l5 > v0) { v0 = l5; i0 = 5; } if (l6 > v0) { v0 = l6; i0 = 6; } if (l7 > v0) { v0 = l7; i0 = 7; }
            int i1 = -1; float v1 = -INFINITY;
            if (i0 != 0 && l0 > v1) { v1 = l0; i1 = 0; } if (i0 != 1 && l1 > v1) { v1 = l1; i1 = 1; } if (i0 != 2 && l2 > v1) { v1 = l2; i1 = 2; } if (i0 != 3 && l3 > v1) { v1 = l3; i1 = 3; }
            if (i0 != 4 && l4 > v1) { v1 = l4; i1 = 4; } if (i0 != 5 && l5 > v1) { v1 = l5; i1 = 5; } if (i0 != 6 && l6 > v1) { v1 = l6; i1 = 6; } if (i0 != 7 && l7 > v1) { v1 = l7; i1 = 7; }
            const float w0 = 1.0f / (1.0f + __expf(v1 - v0));
            if (lane == 0) { tok_e[tok * 2] = i0; tok_e[tok * 2 + 1] = i1; tok_w[tok * 2] = w0; tok_w[tok * 2 + 1] = 1.0f - w0; __hip_atomic_fetch_add(&cnt[i0], 1, __ATOMIC_RELAXED, __HIP_MEMORY_SCOPE_WORKGROUP); __hip_atomic_fetch_add(&cnt[i1], 1, __ATOMIC_RELAXED, __HIP_MEMORY_SCOPE_WORKGROUP); } }
        __syncthreads();
        if (tid < 8) bcnt[grp * 8 + tid] = cnt[tid];
        __syncthreads();
    }
}
__device__ __forceinline__ void moe_gather_phase(const Args& a, Frame& F) {
    unsigned char* ws = a.ws; const int lane = F.lane, w = F.wave, tid = F.tid;
    LAS int* tot = (LAS int*)F.lds; LAS int* pre = tot + 8; LAS int* base = tot + 16; LAS int* rowtab = tot + 32;
    const int* bcnt = (const int*)(ws + WS_BCNT); const int* tok_e = (const int*)(ws + WS_TOKE); int* tok_row = (int*)(ws + WS_TOKR); int* meta = (int*)(ws + WS_META);
    const bf16* Z = (const bf16*)(ws + WS_H); const float* rsh = (const float*)(ws + WS_RSTDQ); unsigned char* AG = ws + WS_AG8;
    for (int grp = (int)blockIdx.x; grp < NT / 64; grp += F.G) {
        if (w < 4) { const int4 c0 = *(const int4*)(bcnt + tid * 8), c1 = *(const int4*)(bcnt + tid * 8 + 4); const int pr = tid < grp ? 1 : 0;
            int v[16] = {c0.x, c0.y, c0.z, c0.w, c1.x, c1.y, c1.z, c1.w, pr * c0.x, pr * c0.y, pr * c0.z, pr * c0.w, pr * c1.x, pr * c1.y, pr * c1.z, pr * c1.w};
#pragma unroll
            for (int k = 0; k < 16; ++k) {
#pragma unroll
                for (int o = 1; o < 64; o <<= 1) v[k] += __shfl_xor(v[k], o);
                if (lane == 0) rowtab[w * 16 + k] = v[k]; } }
        __syncthreads();
        if (tid < 16) tot[tid] = rowtab[tid] + rowtab[16 + tid] + rowtab[32 + tid] + rowtab[48 + tid];
        __syncthreads();
        if (tid == 0) { int tp = 0; for (int e = 0; e < 8; ++e) { base[e] = tp * 256; if (grp == 0) meta[e] = tp; tp += (tot[e] + 255) >> 8; } if (grp == 0) meta[8] = tp; }
        __syncthreads();
        if (w == 0) { const int tok = grp * 64 + lane; const int e0 = tok_e[tok * 2], e1 = tok_e[tok * 2 + 1]; const unsigned long long lt = (1ull << lane) - 1ull;
            int r0 = 0, r1 = 0;
#pragma unroll
            for (int ex = 0; ex < 8; ++ex) { const unsigned long long m0 = __ballot(e0 == ex), m1 = __ballot(e1 == ex); const int b0 = base[ex] + pre[ex], n0 = __popcll(m0);
                if (e0 == ex) r0 = b0 + __popcll(m0 & lt); if (e1 == ex) r1 = b0 + n0 + __popcll(m1 & lt); }
            tok_row[tok * 2] = r0; tok_row[tok * 2 + 1] = r1; rowtab[lane * 2] = r0; rowtab[lane * 2 + 1] = r1; }
        __syncthreads();
        { v4u xa[8], xb[8]; int rows[8]; float rs[8];
#pragma unroll
          for (int hb = 0; hb < 2; ++hb) {
#pragma unroll
            for (int i = 0; i < 8; ++i) { const int pidx = w * 16 + hb * 8 + i; const int tok = grp * 64 + (pidx >> 1); rows[i] = rowtab[pidx]; rs[i] = rsh[tok];
                const v4u* src = (const v4u*)(Z + (size_t)tok * DM) + 2 * lane; xa[i] = src[0]; xb[i] = src[1]; }
#pragma unroll
            for (int i = 0; i < 8; ++i) { const v4u x0 = xa[i], x1 = xb[i]; const float r = rs[i];
                v4u o; o.x = pg8::pk4_fp8(bf_lo(x0.x) * r, bf_hi(x0.x) * r, bf_lo(x0.y) * r, bf_hi(x0.y) * r); o.y = pg8::pk4_fp8(bf_lo(x0.z) * r, bf_hi(x0.z) * r, bf_lo(x0.w) * r, bf_hi(x0.w) * r);
                o.z = pg8::pk4_fp8(bf_lo(x1.x) * r, bf_hi(x1.x) * r, bf_lo(x1.y) * r, bf_hi(x1.y) * r); o.w = pg8::pk4_fp8(bf_lo(x1.z) * r, bf_hi(x1.z) * r, bf_lo(x1.w) * r, bf_hi(x1.w) * r);
                *((v4u*)(AG + (size_t)rows[i] * DM) + lane) = o; } } }
        __syncthreads();
    }
}
__device__ __forceinline__ void moe_combine_phase(const Args& a, Frame& F, const float* gpost) {
    unsigned char* ws = a.ws; const int lane = F.lane; const int gw = F.vcu * NWAVES + F.wave, NGW = F.G * NWAVES;
    const int* tok_row = (const int*)(ws + WS_TOKR); const float* tok_w = (const float*)(ws + WS_TOKW); const bf16* HO = (const bf16*)(ws + WS_HOUT);
    struct CIn { v2u x[4], y[4], hw[4]; float w0, w1; };
#define CB_LOAD(T, C) do { const int r0_ = tok_row[(T) * 2], r1_ = tok_row[(T) * 2 + 1]; C.w0 = tok_w[(T) * 2]; C.w1 = tok_w[(T) * 2 + 1]; \
        const v2u* p0_ = (const v2u*)(HO + (size_t)r0_ * DM) + lane; const v2u* p1_ = (const v2u*)(HO + (size_t)r1_ * DM) + lane; const v2u* hp_ = (const v2u*)((const bf16*)(ws + WS_H) + (size_t)(T) * DM) + lane; \
        _Pragma("unroll") for (int j = 0; j < 4; ++j) { C.x[j] = p0_[64 * j]; C.y[j] = p1_[64 * j]; C.hw[j] = hp_[64 * j]; } } while (0)
#define CB_COMP(T, C) do { f32x4 f[4]; float s = 0.f; const float w0 = C.w0, w1 = C.w1; \
        _Pragma("unroll") for (int j = 0; j < 4; ++j) { const v2u x = C.x[j], y = C.y[j]; \
            f[j] = (f32x4){w0 * bf_lo(x.x) + w1 * bf_lo(y.x), w0 * bf_hi(x.x) + w1 * bf_hi(y.x), w0 * bf_lo(x.y) + w1 * bf_lo(y.y), w0 * bf_hi(x.y) + w1 * bf_hi(y.y)}; \
            s += (f[j].x * f[j].x + f[j].y * f[j].y) + (f[j].z * f[j].z + f[j].w * f[j].w); } \
        const float rstd = 1.0f / sqrtf(wave_sum(s) * (1.f / DM) + NORM_EPS); const f32x4* gp = (const f32x4*)gpost + lane; f32x4* op = (f32x4*)(a.out + (size_t)(T) * DM) + lane; \
        _Pragma("unroll") for (int j = 0; j < 4; ++j) { const v2u hw = C.hw[j]; op[64 * j] = (f32x4){bf_lo(hw.x), bf_hi(hw.x), bf_lo(hw.y), bf_hi(hw.y)} + f[j] * rstd * gp[64 * j]; } } while (0)
    CIn CA, CB; int tok = gw;
    if (tok < NT) CB_LOAD(tok, CA);
    for (; tok < NT; tok += 2 * NGW) {
        if (tok + NGW < NT) CB_LOAD(tok + NGW, CB);
        CB_COMP(tok, CA);
        if (tok + NGW < NT) { if (tok + 2 * NGW < NT) CB_LOAD(tok + 2 * NGW, CA); CB_COMP(tok + NGW, CB); } }
#undef CB_LOAD
#undef CB_COMP
}

constexpr int NPHASE = 19;
#ifndef DBG_STOP
#define DBG_STOP 18
#endif
#ifndef PHMASK
#define PHMASK 0xFFFFFFFFu
#endif
#ifndef REP_MASK
#define REP_MASK 0
#endif
#ifndef P2_DOUBLE
#define P2_DOUBLE 0
#endif
#ifndef ONE_LAUNCH
#define ONE_LAUNCH 1
#endif
__device__ __forceinline__ pg8::TileOrder moe_order(const unsigned char* ws, int nN, int G, int bx) {
    const int* meta = (const int*)(ws + WS_META);
    pg8::TileOrder S; S.init(meta[8], nN, G, bx, 0); S.grouped = true;
    S.tp1 = meta[1]; S.tp2 = meta[2]; S.tp3 = meta[3]; S.tp4 = meta[4]; S.tp5 = meta[5]; S.tp6 = meta[6]; S.tp7 = meta[7];
    return S;
}
__global__ void __launch_bounds__(NTHR, 2) fwd(Args a) {
    extern __shared__ __attribute__((aligned(16))) unsigned char lds[];
    Frame F;
    F.lds = (LAS unsigned char*)lds; F.MISC = (volatile LAS unsigned*)(F.lds + MISC_OFF);
    F.tid = threadIdx.x; F.lane = F.tid & 63; F.wave = __builtin_amdgcn_readfirstlane(F.tid >> 6);
    F.G = gridDim.x; { const int bx = blockIdx.x; F.vcu = (F.G % 8 == 0) ? (bx % 8) * (F.G / 8) + bx / 8 : bx; }
    unsigned char* ws = a.ws; F.ctl = (unsigned*)(ws + WS_CTL);
    for (int u = F.tid; u < 128; u += NTHR) F.MISC[u] = 0u;
    __syncthreads();
    XcdBarrier bar = xcd_barrier_post((unsigned*)(F.ctl + CW_BAR), F.MISC + 8);
    const int lo = a.ph_lo, hi = a.ph_hi;
#define IN(k) (lo <= (k) && (k) < hi)
#define SEAM(k) do { if (IN(k) && IN((k) + 1)) xcd_barrier(bar); } while (0)
    const float* x = a.in[0]; const float* norm_g = a.in[1];
    const int bx = (int)blockIdx.x;

    if (((PHMASK >> 0) & 1) && IN(0)) for (int rep_ = 0; rep_ < ((((unsigned)REP_MASK >> 0) & 1u) ? 2 : 1); ++rep_) { if (rep_) xcd_barrier(bar); p0_prologue(a, F); } SEAM(0);
    if (((PHMASK >> 1) & 1) && IN(1)) for (int rep_ = 0; rep_ < ((((unsigned)REP_MASK >> 1) & 1u) ? 2 : 1); ++rep_) { if (rep_) xcd_barrier(bar);
        pg8::Gemm g{(const bf16*)(ws + WS_Z), (const bf16*)(ws + WS_WIN0), NT, 1536, 1024}; pg8::StaticOrder S; S.init(NT, 1536, F.G, bx);
        pg8::EpiIn0 E{(bf16*)(ws + WS_USSM), (size_t)(WS_GU - WS_USSM) / 2, (const float*)(ws + WS_SA), (const float*)(ws + WS_SB0)};
        pg8::gemm_phase<pg8::EpiIn0, pg8::StaticOrder, true, true, 2>(F.lds, g, S, E);
        moe_convert_slot(a, F, 0, MQ_A);
    } SEAM(1);
    if (((PHMASK >> 2) & 1) && IN(2)) for (int rep_ = 0; rep_ < ((((unsigned)REP_MASK >> 2) & 1u) ? 2 : 1); ++rep_) { if (rep_) xcd_barrier(bar);
        if (F.G >= 256) { if (bx < 128) { ssm_block(a, F, bx); if (P2_DOUBLE == 1) { __syncthreads(); ssm_block(a, F, bx); } } else if (bx < 256) { sgu_block(a, F, bx - 128); if (P2_DOUBLE == 2) { __syncthreads(); sgu_block(a, F, bx - 128); } moe_convert_slot(a, F, MQ_A, MQ_B); } }
        else { for (int it = bx; it < 128; it += F.G) { ssm_block(a, F, it); __syncthreads(); } for (int it = bx; it < 128; it += F.G) { sgu_block(a, F, it); __syncthreads(); } }
    } SEAM(2);
    if (((PHMASK >> 3) & 1) && IN(3)) for (int rep_ = 0; rep_ < ((((unsigned)REP_MASK >> 3) & 1u) ? 2 : 1); ++rep_) { if (rep_) xcd_barrier(bar);
        pg8::Gemm g{(const bf16*)(ws + WS_YB), (const bf16*)(ws + WS_WGLU), NT, 512, 512}; pg8::StaticOrder S; S.init(NT, 512, F.G, bx);
        pg8::EpiGlu E{(const bf16*)(ws + WS_YB), (bf16*)(ws + WS_MIXCAT0)};
        pg8::gemm_phase<pg8::EpiGlu, pg8::StaticOrder, true, true>(F.lds, g, S, E);
        moe_convert_slot(a, F, MQ_B, MQ_C);
    } SEAM(3);
    if (((PHMASK >> 4) & 1) && IN(4)) for (int rep_ = 0; rep_ < ((((unsigned)REP_MASK >> 4) & 1u) ? 2 : 1); ++rep_) { if (rep_) xcd_barrier(bar);
        pg8::Gemm g{(const bf16*)(ws + WS_MIXCAT0), (const bf16*)(ws + WS_WOUT0), NT, 1024, 1024}; pg8::StaticOrder S; S.init(NT, 1024, F.G, bx);
        pg8::EpiPlain E{(bf16*)(ws + WS_MIX), 1024, 4};
        pg8::gemm_phase<pg8::EpiPlain, pg8::StaticOrder, true, true>(F.lds, g, S, E);
    } SEAM(4);
    if (((PHMASK >> 5) & 1) && IN(5)) for (int rep_ = 0; rep_ < ((((unsigned)REP_MASK >> 5) & 1u) ? 2 : 1); ++rep_) { if (rep_) xcd_barrier(bar); resnorm_phase<true, true>(a, F, x, norm_g + 1 * DM); } SEAM(5);

    if (((PHMASK >> 6) & 1) && IN(6)) for (int rep_ = 0; rep_ < ((((unsigned)REP_MASK >> 6) & 1u) ? 2 : 1); ++rep_) { if (rep_) xcd_barrier(bar);
        pg8::Gemm g{(const bf16*)(ws + WS_Z), (const bf16*)(ws + WS_WGU0), NT, 8192, 1024}; pg8::StaticOrder S; S.init(NT, 8192, F.G, bx);
        pg8::EpiSwiGluI8 E{(bf16*)(ws + WS_HFF), 4096, 32, (const float*)(ws + WS_SA), (const float*)(ws + WS_SB)};
        pg8::gemm_phase<pg8::EpiSwiGluI8, pg8::StaticOrder, true, true, 2>(F.lds, g, S, E);
    } SEAM(6);
    if (((PHMASK >> 7) & 1) && IN(7)) for (int rep_ = 0; rep_ < ((((unsigned)REP_MASK >> 7) & 1u) ? 2 : 1); ++rep_) { if (rep_) xcd_barrier(bar);
        pg8::Gemm g{(const bf16*)(ws + WS_HFF), (const bf16*)(ws + WS_WDN0), NT, 1024, 4096}; pg8::StaticOrder S; S.init(NT, 1024, F.G, bx);
        pg8::EpiPlain E{(bf16*)(ws + WS_MIX), 1024, 4};
        pg8::gemm_phase<pg8::EpiPlain, pg8::StaticOrder, true, true>(F.lds, g, S, E);
    } SEAM(7);
    if (((PHMASK >> 8) & 1) && IN(8)) for (int rep_ = 0; rep_ < ((((unsigned)REP_MASK >> 8) & 1u) ? 2 : 1); ++rep_) { if (rep_) xcd_barrier(bar); resnorm_phase<false, true>(a, F, ws + WS_H, norm_g + 3 * DM); } SEAM(8);

    if (((PHMASK >> 9) & 1) && IN(9)) for (int rep_ = 0; rep_ < ((((unsigned)REP_MASK >> 9) & 1u) ? 2 : 1); ++rep_) { if (rep_) xcd_barrier(bar);
        pg8::Gemm g{(const bf16*)(ws + WS_Z), (const bf16*)(ws + WS_WIN1), NT, 1536, 1024}; pg8::StaticOrder S; S.init(NT, 1536, F.G, bx);
        pg8::EpiIn1 E{(bf16*)(ws + WS_HGLU), (bf16*)(ws + WS_CQ), (size_t)(WS_CKV - WS_CQ) / 2, (const float*)(ws + WS_SA), (const float*)(ws + WS_SB1)};
        pg8::gemm_phase<pg8::EpiIn1, pg8::StaticOrder, true, true, 2>(F.lds, g, S, E);
        moe_convert_slot(a, F, MQ_C, MQ_D);
    } SEAM(9);
    if (((PHMASK >> 10) & 1) && IN(10)) for (int rep_ = 0; rep_ < ((((unsigned)REP_MASK >> 10) & 1u) ? 2 : 1); ++rep_) { if (rep_) xcd_barrier(bar); conv_prep_phase(a, F); } SEAM(10);
    if (((PHMASK >> 11) & 1) && IN(11)) for (int rep_ = 0; rep_ < ((((unsigned)REP_MASK >> 11) & 1u) ? 2 : 1); ++rep_) { if (rep_) xcd_barrier(bar);
        { pg8::Gemm g{(const bf16*)(ws + WS_CQ), (const bf16*)(ws + WS_WUQ), NT, 768, 256}; pg8::StaticOrder S; S.init(NT, 768, F.G, bx);
          pg8::EpiQ E{(bf16*)(ws + WS_Q), (const float*)(ws + WS_ROPE), 0.10206207261596577f * 1.4426950408889634f};
          pg8::gemm_phase<pg8::EpiQ, pg8::StaticOrder, true, true>(F.lds, g, S, E); }
        { pg8::Gemm g{(const bf16*)(ws + WS_CKV), (const bf16*)(ws + WS_WUKV), NT, 1024, 256}; pg8::StaticOrder S; S.init(NT, 1024, F.G, bx);
          pg8::EpiKV E{(bf16*)(ws + WS_KK), (bf16*)(ws + WS_VV)};
          pg8::gemm_phase<pg8::EpiKV, pg8::StaticOrder, true, true>(F.lds, g, S, E); }
    } SEAM(11);
    if (((PHMASK >> 12) & 1) && IN(12)) for (int rep_ = 0; rep_ < ((((unsigned)REP_MASK >> 12) & 1u) ? 2 : 1); ++rep_) { if (rep_) xcd_barrier(bar); attn_phase(a, F); } SEAM(12);
    if (((PHMASK >> 13) & 1) && IN(13)) for (int rep_ = 0; rep_ < ((((unsigned)REP_MASK >> 13) & 1u) ? 2 : 1); ++rep_) { if (rep_) xcd_barrier(bar);
        pg8::Gemm g{(const bf16*)(ws + WS_MIXCAT1), (const bf16*)(ws + WS_WOUT1), NT, 1024, 1024}; pg8::StaticOrder S; S.init(NT, 1024, F.G, bx);
        pg8::EpiPlain E{(bf16*)(ws + WS_MIX), 1024, 4};
        pg8::gemm_phase<pg8::EpiPlain, pg8::StaticOrder, true, true>(F.lds, g, S, E);
    } SEAM(13);
    if (((PHMASK >> 14) & 1) && IN(14)) for (int rep_ = 0; rep_ < ((((unsigned)REP_MASK >> 14) & 1u) ? 2 : 1); ++rep_) { if (rep_) xcd_barrier(bar); resnorm_router_phase(a, F, norm_g + 5 * DM, norm_g + 6 * DM); } SEAM(14);
    if (((PHMASK >> 15) & 1) && IN(15)) for (int rep_ = 0; rep_ < ((((unsigned)REP_MASK >> 15) & 1u) ? 2 : 1); ++rep_) { if (rep_) xcd_barrier(bar); moe_gather_phase(a, F); moe_convert_all(a, F); } SEAM(15);
    if (((PHMASK >> 16) & 1) && IN(16)) for (int rep_ = 0; rep_ < ((((unsigned)REP_MASK >> 16) & 1u) ? 2 : 1); ++rep_) { if (rep_) xcd_barrier(bar);
        pg8::TileOrder S = moe_order(ws, 28, F.G, bx); pg8::Gemm g{(const bf16*)(ws + WS_AG8), (const bf16*)(ws + WS_WGU1), 0, 0, 1024, 0x7F7F7F7F, 0x79797979};
        pg8::EpiSwiGlu8 E{ws + WS_HMOE8, 3584, 28, 8.0f};
        pg8::gemm_phase<pg8::EpiSwiGlu8, pg8::TileOrder, true, true, true>(F.lds, g, S, E);
    } SEAM(16);
    if (((PHMASK >> 17) & 1) && IN(17)) for (int rep_ = 0; rep_ < ((((unsigned)REP_MASK >> 17) & 1u) ? 2 : 1); ++rep_) { if (rep_) xcd_barrier(bar);
        pg8::TileOrder S = moe_order(ws, 4, F.G, bx); pg8::Gemm g{(const bf16*)(ws + WS_HMOE8), (const bf16*)(ws + WS_WDN1), 0, 0, 3584, 0x7C7C7C7C, 0x78787878};
        pg8::EpiPlain E{(bf16*)(ws + WS_HOUT), 1024, 4};
        pg8::gemm_phase<pg8::EpiPlain, pg8::TileOrder, true, true, true>(F.lds, g, S, E);
    } SEAM(17);
    if (((PHMASK >> 18) & 1) && IN(18)) for (int rep_ = 0; rep_ < ((((unsigned)REP_MASK >> 18) & 1u) ? 2 : 1); ++rep_) { if (rep_) xcd_barrier(bar); moe_combine_phase(a, F, norm_g + 7 * DM); }

    if (IN(99)) {
        const f32x4* src = (const f32x4*)x; f32x4* dst = (f32x4*)a.out;
        for (size_t i = (size_t)bx * NTHR + F.tid; i < (size_t)NT * DM / 4; i += (size_t)F.G * NTHR) dst[i] = src[i];
    }
#undef IN
#undef SEAM
}

static void fill_desc(TDesc& d, const float* W, bf16* WT, const float* gain, int ldw, int K, int N, int Kd, int map, int roff, int nb, long sstride, long dstride, int& item0, float scale = 1.0f, int fp8 = 0) {
    d.W = W; d.WT = WT; d.gain = gain; d.sstride = sstride; d.dstride = dstride; d.ldw = ldw; d.K = K; d.N = N; d.Kd = Kd; d.map = map; d.roff = roff; d.nb = nb; d.item0 = item0; d.scale = scale; d.fp8 = fp8;
    if (fp8 != 2) item0 += nb * (K / 64) * (N / 32);
}
extern "C" void kernel_launch(void* const* d_in, const int* in_sizes, int n_in, void* d_out, int out_size, void* d_ws, size_t ws_size, hipStream_t stream) {
    static int grid = 0;
    if (grid == 0) {
        if (n_in != 34 || out_size != NT * DM || ws_size < WS_END) { fprintf(stderr, "kernel_launch: unexpected shapes (n_in %d, out %d, ws %zu < %zu)\n", n_in, out_size, ws_size, (size_t)WS_END); grid = -1; return; }
        int dev = 0, cus = 0, per_cu = 0;
        if (hipGetDevice(&dev) != hipSuccess || hipDeviceGetAttribute(&cus, hipDeviceAttributeMultiprocessorCount, dev) != hipSuccess) { grid = -1; return; }
        if (hipFuncSetAttribute((const void*)fwd, hipFuncAttributeMaxDynamicSharedMemorySize, LDS_BYTES) != hipSuccess) { fprintf(stderr, "kernel_launch: hipFuncSetAttribute failed\n"); grid = -1; return; }
        if (hipOccupancyMaxActiveBlocksPerMultiprocessor(&per_cu, (const void*)fwd, NTHR, LDS_BYTES) != hipSuccess || per_cu < 1) { fprintf(stderr, "kernel_launch: occupancy query says %d\n", per_cu); }
        (void)hipGetLastError();
        grid = cus;
    }
    if (grid < 0) return;
    unsigned char* ws = (unsigned char*)d_ws;
    (void)hipMemsetAsync(ws + WS_CTL, 0, CTL_ZERO_BYTES, stream);
    Args a{};
    for (int i = 0; i < 34; ++i) a.in[i] = (const float*)d_in[i];
    a.out = (float*)d_out; a.ws = ws;
    const float* ng = a.in[1]; int it0 = 0;
    fill_desc(a.td[0], a.in[2], (bf16*)(ws + WS_WIN0), ng + 0 * DM, 1536, 1024, 1536, 1024, 0, 0, 1, 0, 0, it0, 1.0f, 2);
    fill_desc(a.td[1], a.in[11], (bf16*)(ws + WS_WGLU), nullptr, 512, 512, 512, 512, 0, 0, 1, 0, 0, it0);
    fill_desc(a.td[2], a.in[16], (bf16*)(ws + WS_WOUT0), nullptr, 1024, 1024, 1024, 1024, 0, 0, 1, 0, 0, it0);
    fill_desc(a.td[3], a.in[17], (bf16*)(ws + WS_WGU0), ng + 2 * DM, 4096, 1024, 4096, 1024, 1, 0, 1, 0, 0, it0, 1.0f, 2);
    fill_desc(a.td[4], a.in[18], (bf16*)(ws + WS_WGU0), ng + 2 * DM, 4096, 1024, 4096, 1024, 2, 0, 1, 0, 0, it0, 1.0f, 2);
    fill_desc(a.td[5], a.in[19], (bf16*)(ws + WS_WDN0), nullptr, 1024, 4096, 1024, 4096, 0, 0, 1, 0, 0, it0);
    fill_desc(a.td[6], a.in[20], (bf16*)(ws + WS_WIN1), ng + 4 * DM, 1440, 1024, 512, 1024, 1, 0, 1, 0, 0, it0, 1.0f, 2);
    fill_desc(a.td[7], a.in[20] + 512, (bf16*)(ws + WS_WIN1), ng + 4 * DM, 1440, 1024, 512, 1024, 2, 0, 1, 0, 0, it0, 1.0f, 2);
    fill_desc(a.td[8], a.in[20] + 1024, (bf16*)(ws + WS_WIN1), ng + 4 * DM, 1440, 1024, 416, 1024, 0, 1024, 1, 0, 0, it0, 1.0f, 2);
    fill_desc(a.td[9], a.in[26], (bf16*)(ws + WS_WUQ), a.in[25], 768, 256, 768, 256, 0, 0, 1, 0, 0, it0);
    fill_desc(a.td[10], a.in[28], (bf16*)(ws + WS_WUKV), a.in[27], 1024, 128, 1024, 256, 0, 0, 1, 0, 0, it0);
    fill_desc(a.td[11], a.in[29], (bf16*)(ws + WS_WOUT1), nullptr, 1024, 1024, 1024, 1024, 0, 0, 1, 0, 0, it0);
    fill_desc(a.td[12], a.in[31], (bf16*)(ws + WS_WGU1), ng + 6 * DM, 3584, 1024, 3584, 1024, 1, 0, 8, (long)1024 * 3584, (long)7168 * 1024, it0, 64.0f, 1);
    fill_desc(a.td[13], a.in[32], (bf16*)(ws + WS_WGU1), ng + 6 * DM, 3584, 1024, 3584, 1024, 2, 0, 8, (long)1024 * 3584, (long)7168 * 1024, it0, 64.0f, 1);
    fill_desc(a.td[14], a.in[33], (bf16*)(ws + WS_WDN1), nullptr, 1024, 3584, 1024, 3584, 0, 0, 8, (long)3584 * 1024, (long)1024 * 3584, it0, 128.0f, 1);
    a.n_items = it0;
    const int last = DBG_STOP;
#if ONE_LAUNCH
    a.ph_lo = 0; a.ph_hi = last + 1; a.dbg = 0;
    hipLaunchKernelGGL(fwd, dim3(grid), dim3(NTHR), LDS_BYTES, stream, a);
#else
    for (int p = 0; p <= last; ++p) { a.ph_lo = p; a.ph_hi = p + 1; a.dbg = 0; hipLaunchKernelGGL(fwd, dim3(grid), dim3(NTHR), LDS_BYTES, stream, a); }
#endif
    if (last < NPHASE - 1) { a.ph_lo = 99; a.ph_hi = 100; a.dbg = 1; hipLaunchKernelGGL(fwd, dim3(grid), dim3(NTHR), LDS_BYTES, stream, a); }
}
```

```cpp
#include <hip/hip_runtime.h>
#include <cstdio>
#include <cstdint>
namespace pg8 {
#define PG8_LAS __attribute__((address_space(3)))
typedef unsigned short bf16_t;
typedef short bf16x8 __attribute__((ext_vector_type(8)));
typedef float f32x4 __attribute__((ext_vector_type(4)));
typedef unsigned u32x4 __attribute__((ext_vector_type(4)));
constexpr int BM = 256, BK = 64, HALF = 128, HTB = HALF * BK * 2  , STAGE_BYTES = 8 * HTB, NXCD = 8, WGM = 8;

__host__ __device__ __forceinline__ int lds_byte(int r, int c) { const int st = (r >> 4) * 2 + (c >> 5), rr = r & 15, cc = c & 31, ob = rr * 64 + cc * 2; return st * 1024 + (ob ^ (((ob >> 9) & 1) << 5)); }
__host__ __device__ __forceinline__ void stage_rc(int b, int& R, int& C) { const int st = b / 1024, sb = b % 1024, swz = sb ^ (((sb >> 9) & 1) << 5); R = (st >> 1) * 16 + swz / 64; C = (st & 1) * 32 + (swz % 64) / 2; }
__host__ __device__ __forceinline__ int perm32(int rho) { const int n = rho >> 4, i = rho & 15; return 8 * (i >> 2) + 4 * n + (i & 3); }

struct Unit { int pm, pn, kb; };
typedef int v4i_t __attribute__((ext_vector_type(4))); typedef int v8i_t __attribute__((ext_vector_type(8)));
struct Gemm { const bf16_t* A; const bf16_t* Bt; int M, N, K; int sa, sb; int rb; };

struct StaticOrder {
    int nM, nN, nwg, G, c;
    __host__ __device__ void init(int M, int N, int G_, int c_) { nM = M / BM; nN = N / BM; nwg = nM * nN; G = G_; c = c_; }
    __host__ __device__ bool next(int i, Unit& u) const {
        const long L = (long)i * G + c; if (L >= nwg) return false;
        int wgid = (int)L; { const int q = nwg / NXCD, r = nwg % NXCD, xcd = wgid % NXCD, off = wgid / NXCD; wgid = (xcd < r ? xcd * (q + 1) : r * (q + 1) + (xcd - r) * q) + off; }
        const int nig = WGM * nN, gid = wgid / nig, fm = gid * WGM, gsz = (nM - fm) < WGM ? (nM - fm) : WGM;
        u.pm = fm + ((wgid % nig) % gsz); u.pn = (wgid % nig) / gsz; return true;
    }
    __device__ __forceinline__ void a_ready(const Unit&) const {}
    __device__ __forceinline__ void done(const Unit&) const {}
};


typedef unsigned u32x2 __attribute__((ext_vector_type(2)));
__device__ __forceinline__ unsigned cvt_pk_bf16(float lo, float hi) { unsigned r; asm volatile("v_cvt_pk_bf16_f32 %0, %1, %2" : "=v"(r) : "v"(lo), "v"(hi)); return r; }
__device__ __forceinline__ float bf_lo(unsigned u) { return __uint_as_float(u << 16); }
__device__ __forceinline__ float bf_hi(unsigned u) { return __uint_as_float(u & 0xffff0000u); }
__device__ __forceinline__ float sigmoid_f(float x) { return __builtin_amdgcn_rcpf(1.0f + __builtin_amdgcn_exp2f(-1.4426950408889634f * x)); }
__device__ __forceinline__ float silu_f(float x) { return x * sigmoid_f(x); }
__device__ __forceinline__ float gelu_f(float x) { const float t = x * (1.5957691216057308f + 0.07135481627f * x * x); return x * sigmoid_f(t); }
__device__ __forceinline__ f32x4 exp2_4(const f32x4 x) { return (f32x4){__builtin_amdgcn_exp2f(x.x), __builtin_amdgcn_exp2f(x.y), __builtin_amdgcn_exp2f(x.z), __builtin_amdgcn_exp2f(x.w)}; }
__device__ __forceinline__ f32x4 rcp_4(const f32x4 x) { return (f32x4){__builtin_amdgcn_rcpf(x.x), __builtin_amdgcn_rcpf(x.y), __builtin_amdgcn_rcpf(x.z), __builtin_amdgcn_rcpf(x.w)}; }
__device__ __forceinline__ f32x4 sigmoid4(const f32x4 x) { return rcp_4(exp2_4(x * -1.4426950408889634f) + 1.0f); }
__device__ __forceinline__ f32x4 gelu4(const f32x4 x) { const f32x4 t = x * (x * x * 0.07135481627f + 1.5957691216057308f); return x * sigmoid4(t); }
__device__ __forceinline__ u32x4 pack8(const f32x4& v0, const f32x4& v1) { u32x4 w; w.x = cvt_pk_bf16(v0[0], v0[1]); w.y = cvt_pk_bf16(v0[2], v0[3]); w.z = cvt_pk_bf16(v1[0], v1[1]); w.w = cvt_pk_bf16(v1[2], v1[3]); return w; }

#ifndef EPI_PROBE
#define EPI_PROBE 0
#endif
#ifndef EPI_NT
#define EPI_NT 0
#endif
#ifndef EPI_WT
#define EPI_WT 0
#endif
__device__ __forceinline__ void st16(void* p, u32x4 v) {
#if EPI_WT
    asm volatile("global_store_dwordx4 %0, %1, off sc1\n\ts_nop 1" :: "v"(p), "v"(v) : "memory");
#elif EPI_NT
    __builtin_nontemporal_store(v, (u32x4*)p);
#else
    *(u32x4*)p = v;
#endif
}
__device__ __forceinline__ void st8(void* p, u32x2 v) {
#if EPI_WT
    asm volatile("global_store_dwordx2 %0, %1, off sc1" :: "v"(p), "v"(v) : "memory");
#elif EPI_NT
    __builtin_nontemporal_store(v, (u32x2*)p);
#else
    *(u32x2*)p = v;
#endif
}
struct EpiPlain {
    static constexpr int NSTORE = 16;
    static constexpr bool PERM = true, AFTER_DRAIN = false;
    bf16_t* O; int ldc; int nNloc;
    __device__ __forceinline__ void operator()(const f32x4 (&acc)[2][2][4][2], const Unit& u, int wr, int wc, int fr, int fq) const {
        const int row0 = u.pm * BM + wr * 64 + fr, col0 = (u.pn % nNloc) * BM + wc * 32 + 8 * fq;
#pragma unroll
        for (int ai = 0; ai < 2; ++ai)
#pragma unroll
            for (int m = 0; m < 4; ++m) { bf16_t* rowp = O + (size_t)(row0 + ai * HALF + m * 16) * ldc + col0;
#pragma unroll
                for (int bj = 0; bj < 2; ++bj) st16(rowp + bj * HALF, pack8(acc[ai][bj][m][0], acc[ai][bj][m][1])); }
    }
};
struct EpiIn0 {
    static constexpr int NSTORE = 16;
    static constexpr bool PERM = true, AFTER_DRAIN = false;
    bf16_t* ussm; size_t dstride; const float* sA; const float* sB;
    __device__ __forceinline__ void operator()(const f32x4 (&acc)[2][2][4][2], const Unit& u, int wr, int wc, int fr, int fq) const {
        const int dest = u.pn >> 1; bf16_t* base = ussm + (size_t)dest * dstride;
        const int row0 = u.pm * BM + wr * 64 + fr, col0 = (u.pn & 1) * BM + wc * 32 + 8 * fq, cb = u.pn * BM + wc * 32 + 8 * fq;
        f32x4 sb[2][2];
#pragma unroll
        for (int bj = 0; bj < 2; ++bj) { sb[bj][0] = *(const f32x4*)(sB + cb + bj * HALF); sb[bj][1] = *(const f32x4*)(sB + cb + bj * HALF + 4); }
#pragma unroll
        for (int ai = 0; ai < 2; ++ai)
#pragma unroll
            for (int m = 0; m < 4; ++m) { const float ra = sA[row0 + ai * HALF + m * 16]; bf16_t* rowp = base + (size_t)(row0 + ai * HALF + m * 16) * 512 + col0;
#pragma unroll
                for (int bj = 0; bj < 2; ++bj) { f32x4 v0 = __builtin_convertvector(__builtin_bit_cast(v4i_t, acc[ai][bj][m][0]), f32x4) * (sb[bj][0] * ra), v1 = __builtin_convertvector(__builtin_bit_cast(v4i_t, acc[ai][bj][m][1]), f32x4) * (sb[bj][1] * ra);
                    if (dest) { v0 = gelu4(v0); v1 = gelu4(v1); }
                    st16(rowp + bj * HALF, pack8(v0, v1)); } }
    }
};
struct EpiGlu {
    static constexpr int NSTORE = 16;
    static constexpr bool PERM = true, AFTER_DRAIN = false;
    const bf16_t* Y; bf16_t* O;
    __device__ __forceinline__ void operator()(const f32x4 (&acc)[2][2][4][2], const Unit& u, int wr, int wc, int fr, int fq) const {
        const int row0 = u.pm * BM + wr * 64 + fr, col0 = u.pn * BM + wc * 32 + 8 * fq;
#pragma unroll
        for (int ai = 0; ai < 2; ++ai)
#pragma unroll
            for (int m = 0; m < 4; ++m) { const size_t r = (size_t)(row0 + ai * HALF + m * 16);
#pragma unroll
                for (int bj = 0; bj < 2; ++bj) { const u32x4 y = *(const u32x4*)(Y + r * 512 + col0 + bj * HALF);
                    const f32x4 y0 = {bf_lo(y.x), bf_hi(y.x), bf_lo(y.y), bf_hi(y.y)}, y1 = {bf_lo(y.z), bf_hi(y.z), bf_lo(y.w), bf_hi(y.w)};
                    const f32x4 v0 = y0 * sigmoid4(acc[ai][bj][m][0]), v1 = y1 * sigmoid4(acc[ai][bj][m][1]);
                    st16(O + r * 1024 + col0 + bj * HALF, pack8(v0, v1)); } }
    }
};
struct EpiSwiGlu {
    static constexpr int NSTORE = 8;
    static constexpr bool PERM = true, AFTER_DRAIN = false;
    bf16_t* O; int ldo; int nNloc; const float* rstd;
    __device__ __forceinline__ void operator()(const f32x4 (&acc)[2][2][4][2], const Unit& u, int wr, int wc, int fr, int fq) const {
        const int row0 = u.pm * BM + wr * 64 + fr, col0 = (u.pn % nNloc) * HALF + wc * 32 + 8 * fq;
#pragma unroll
        for (int ai = 0; ai < 2; ++ai)
#pragma unroll
            for (int m = 0; m < 4; ++m) { const int row = row0 + ai * HALF + m * 16; const float rs = rstd[row];
                const float c1 = -1.4426950408889634f * rs, rs2 = rs * rs; const f32x4 g0 = acc[ai][0][m][0], g1 = acc[ai][0][m][1];
                const f32x4 v0 = (g0 * acc[ai][1][m][0]) * (rcp_4(exp2_4(g0 * c1) + 1.0f) * rs2), v1 = (g1 * acc[ai][1][m][1]) * (rcp_4(exp2_4(g1 * c1) + 1.0f) * rs2);
                st16(O + (size_t)row * ldo + col0, pack8(v0, v1)); }
    }
};
struct EpiSwiGluI8 {
    static constexpr int NSTORE = 8;
    static constexpr bool PERM = true, AFTER_DRAIN = false;
    bf16_t* O; int ldo; int nNloc; const float* sA; const float* sB;
    __device__ __forceinline__ void operator()(const f32x4 (&acc)[2][2][4][2], const Unit& u, int wr, int wc, int fr, int fq) const {
        const int row0 = u.pm * BM + wr * 64 + fr, col0 = (u.pn % nNloc) * HALF + wc * 32 + 8 * fq, cb = u.pn * BM + wc * 32 + 8 * fq;
        const f32x4 sg0 = *(const f32x4*)(sB + cb), sg1 = *(const f32x4*)(sB + cb + 4), su0 = *(const f32x4*)(sB + cb + HALF), su1 = *(const f32x4*)(sB + cb + HALF + 4);
#if EPI_PROBE == 2
        for (int rep = 0; rep < 2; ++rep) { asm volatile("" ::: "memory");
#endif
#pragma unroll
        for (int ai = 0; ai < 2; ++ai)
#pragma unroll
            for (int m = 0; m < 4; ++m) { const int row = row0 + ai * HALF + m * 16; const float a = sA[row];
                const f32x4 g0 = __builtin_convertvector(__builtin_bit_cast(v4i_t, acc[ai][0][m][0]), f32x4) * (sg0 * a), g1 = __builtin_convertvector(__builtin_bit_cast(v4i_t, acc[ai][0][m][1]), f32x4) * (sg1 * a);
                const f32x4 u0 = __builtin_convertvector(__builtin_bit_cast(v4i_t, acc[ai][1][m][0]), f32x4) * (su0 * a), u1 = __builtin_convertvector(__builtin_bit_cast(v4i_t, acc[ai][1][m][1]), f32x4) * (su1 * a);
                const f32x4 v0 = (g0 * u0) * sigmoid4(g0), v1 = (g1 * u1) * sigmoid4(g1);
                st16(O + (size_t)row * ldo + col0, pack8(v0, v1)); }
#if EPI_PROBE == 2
        }
#endif
    }
};
__device__ __forceinline__ unsigned pk4_fp8(float a, float b, float c, float d) { unsigned w = 0u; w = __builtin_amdgcn_cvt_pk_fp8_f32(a, b, w, false); w = __builtin_amdgcn_cvt_pk_fp8_f32(c, d, w, true); return w; }
__device__ __forceinline__ float clamp448(float x) { return __builtin_fminf(__builtin_fmaxf(x, -448.f), 448.f); }
struct EpiSwiGlu8 {
    static constexpr int NSTORE = 8;
    static constexpr bool PERM = true, AFTER_DRAIN = false;
    unsigned char* O; int ldo; int nNloc; float hs;
    __device__ __forceinline__ void operator()(const f32x4 (&acc)[2][2][4][2], const Unit& u, int wr, int wc, int fr, int fq) const {
#if EPI_PROBE == 1
        for (int rep = 0; rep < 2; ++rep) { asm volatile("" ::: "memory");
#endif
        const int row0 = u.pm * BM + wr * 64 + fr, col0 = (u.pn % nNloc) * HALF + wc * 32 + 8 * fq;
#pragma unroll
        for (int ai = 0; ai < 2; ++ai)
#pragma unroll
            for (int m = 0; m < 4; ++m) { const f32x4 g0 = acc[ai][0][m][0], g1 = acc[ai][0][m][1];
                f32x4 v0 = (g0 * acc[ai][1][m][0]) * (rcp_4(exp2_4(g0 * -1.4426950408889634f) + 1.0f) * hs), v1 = (g1 * acc[ai][1][m][1]) * (rcp_4(exp2_4(g1 * -1.4426950408889634f) + 1.0f) * hs);
                v0 = __builtin_elementwise_min(__builtin_elementwise_max(v0, (f32x4){-448.f, -448.f, -448.f, -448.f}), (f32x4){448.f, 448.f, 448.f, 448.f});
                v1 = __builtin_elementwise_min(__builtin_elementwise_max(v1, (f32x4){-448.f, -448.f, -448.f, -448.f}), (f32x4){448.f, 448.f, 448.f, 448.f});
                u32x2 w; w.x = pk4_fp8(v0.x, v0.y, v0.z, v0.w); w.y = pk4_fp8(v1.x, v1.y, v1.z, v1.w);
                st8(O + (size_t)(row0 + ai * HALF + m * 16) * ldo + col0, w); }
#if EPI_PROBE == 1
        }
#endif
    }
};
struct EpiIn1 {
    static constexpr int NSTORE = 8;
    static constexpr bool PERM = true, AFTER_DRAIN = false;
    bf16_t* hglu; bf16_t* cq; size_t cstride; const float* sA; const float* sB; float* rss;
    __device__ __forceinline__ void operator()(const f32x4 (&acc)[2][2][4][2], const Unit& u, int wr, int wc, int fr, int fq) const {
        const int row0 = u.pm * BM + wr * 64 + fr, cb = u.pn * BM + wc * 32 + 8 * fq;
        f32x4 sb[2][2];
#pragma unroll
        for (int bj = 0; bj < 2; ++bj) { sb[bj][0] = *(const f32x4*)(sB + cb + bj * HALF); sb[bj][1] = *(const f32x4*)(sB + cb + bj * HALF + 4); }
        if (u.pn < 4) {
            const int col0 = u.pn * HALF + wc * 32 + 8 * fq;
#pragma unroll
            for (int ai = 0; ai < 2; ++ai)
#pragma unroll
                for (int m = 0; m < 4; ++m) { const float ra = sA[row0 + ai * HALF + m * 16];
                    const f32x4 a0 = __builtin_convertvector(__builtin_bit_cast(v4i_t, acc[ai][0][m][0]), f32x4) * (sb[0][0] * ra), a1 = __builtin_convertvector(__builtin_bit_cast(v4i_t, acc[ai][0][m][1]), f32x4) * (sb[0][1] * ra);
                    const f32x4 g0 = __builtin_convertvector(__builtin_bit_cast(v4i_t, acc[ai][1][m][0]), f32x4) * (sb[1][0] * ra), g1 = __builtin_convertvector(__builtin_bit_cast(v4i_t, acc[ai][1][m][1]), f32x4) * (sb[1][1] * ra);
                    const f32x4 v0 = a0 * sigmoid4(g0), v1 = a1 * sigmoid4(g1);
                    st16(hglu + (size_t)(row0 + ai * HALF + m * 16) * 512 + col0, pack8(v0, v1)); }
        } else {
            bf16_t* base = cq + (size_t)(u.pn - 4) * cstride; const int col0 = wc * 32 + 8 * fq;
#pragma unroll
            for (int ai = 0; ai < 2; ++ai)
#pragma unroll
                for (int m = 0; m < 4; ++m) { const int row = row0 + ai * HALF + m * 16; const float ra = sA[row]; bf16_t* rowp = base + (size_t)row * 256 + col0; float ss = 0.f;
#pragma unroll
                    for (int bj = 0; bj < 2; ++bj) { const f32x4 v0 = __builtin_convertvector(__builtin_bit_cast(v4i_t, acc[ai][bj][m][0]), f32x4) * (sb[bj][0] * ra), v1 = __builtin_convertvector(__builtin_bit_cast(v4i_t, acc[ai][bj][m][1]), f32x4) * (sb[bj][1] * ra);
                        if (bj == 0 || u.pn == 4) ss += ((v0.x * v0.x + v0.y * v0.y) + (v0.z * v0.z + v0.w * v0.w)) + ((v1.x * v1.x + v1.y * v1.y) + (v1.z * v1.z + v1.w * v1.w));
                        st16(rowp + bj * HALF, pack8(v0, v1)); }
                    ss += __shfl_xor(ss, 16); ss += __shfl_xor(ss, 32);
                    if (fq == 0) rss[((size_t)(u.pn - 4) * 16384 + row) * 4 + wc] = ss; }
        }
    }
};
struct EpiQ {
    static constexpr int NSTORE = 32;
    static constexpr bool PERM = false, AFTER_DRAIN = false;
    bf16_t* Q; const float* cs;
    float c2; const float* rss;
    __device__ __forceinline__ void operator()(const f32x4 (&acc)[2][2][4][2], const Unit& u, int wr, int wc, int fr, int fq) const {
        const int row0 = u.pm * BM + wr * 64 + fr;
#pragma unroll
        for (int ai = 0; ai < 2; ++ai)
#pragma unroll
            for (int m = 0; m < 4; ++m) { const int row = row0 + ai * HALF + m * 16; const f32x4 sq = *(const f32x4*)(rss + (size_t)row * 4); const float rs = c2 * __builtin_amdgcn_rsqf(((sq.x + sq.y) + (sq.z + sq.w)) * (1.f / 256.f) + 1e-6f); const float* csr = cs + (size_t)(row & 4095) * 32 + 4 * fq;
                const f32x4 co = *(const f32x4*)csr, si = *(const f32x4*)(csr + 16);
#pragma unroll
                for (int bj = 0; bj < 2; ++bj) { const int g32 = 8 * u.pn + 4 * bj + wc; f32x4 x0 = acc[ai][bj][m][0], x1 = acc[ai][bj][m][1];
                    if (g32 % 3 == 2) { const f32x4 y0 = x0 * co - x1 * si, y1 = x1 * co + x0 * si; x0 = y0; x1 = y1; }
                    x0 = x0 * rs; x1 = x1 * rs;
                    bf16_t* p = Q + (size_t)row * 768 + u.pn * BM + bj * HALF + wc * 32 + 4 * fq;
                    u32x2 w0, w1; w0.x = cvt_pk_bf16(x0[0], x0[1]); w0.y = cvt_pk_bf16(x0[2], x0[3]); w1.x = cvt_pk_bf16(x1[0], x1[1]); w1.y = cvt_pk_bf16(x1[2], x1[3]);
                    st8(p, w0); st8(p + 16, w1); }
                asm volatile("" ::: "memory"); }
    }
};
struct EpiKV {
    static constexpr int NSTORE = 16;
    static constexpr bool PERM = true, AFTER_DRAIN = false;
    bf16_t* KK; bf16_t* VV; const float* rss;
    __device__ __forceinline__ void operator()(const f32x4 (&acc)[2][2][4][2], const Unit& u, int wr, int wc, int fr, int fq) const {
        const int row0 = u.pm * BM + wr * 64 + fr;
#pragma unroll
        for (int ai = 0; ai < 2; ++ai)
#pragma unroll
            for (int m = 0; m < 4; ++m) { const int row = row0 + ai * HALF + m * 16; const f32x4 sq = *(const f32x4*)(rss + (size_t)row * 4); const float rk = __builtin_amdgcn_rsqf(((sq.x + sq.y) + (sq.z + sq.w)) * (1.f / 128.f) + 1e-6f);
#pragma unroll
                for (int bj = 0; bj < 2; ++bj) { const int h = 2 * u.pn + bj; const f32x4 v0 = acc[ai][bj][m][0] * rk, v1 = acc[ai][bj][m][1] * rk;
                    bf16_t* p = wc < 2 ? KK + (size_t)row * 768 + h * 96 + wc * 32 + 8 * fq : VV + (size_t)row * 512 + h * 64 + (wc - 2) * 32 + 8 * fq;
                    st16(p, pack8(v0, v1)); }
                asm volatile("" ::: "memory"); }
    }
};
constexpr int SPLIT_T0 = 128, SPLIT_S = 7, SPLIT_RT = 8, SPLIT_KB = 512;
struct EpiPart {
    static constexpr int NSTORE = 16;
    static constexpr bool PERM = true, AFTER_DRAIN = false;
    bf16_t* P; int nNloc;
    __device__ __forceinline__ void operator()(const f32x4 (&acc)[2][2][4][2], const Unit& u, int wr, int wc, int fr, int fq) const {
        bf16_t* O = P + ((size_t)(u.kb / SPLIT_KB) * SPLIT_RT + (u.pm - SPLIT_T0)) * (256 * 1024);
        const int row0 = wr * 64 + fr, col0 = (u.pn % nNloc) * BM + wc * 32 + 8 * fq;
#pragma unroll
        for (int ai = 0; ai < 2; ++ai)
#pragma unroll
            for (int m = 0; m < 4; ++m) { bf16_t* rowp = O + (size_t)(row0 + ai * HALF + m * 16) * 1024 + col0;
#pragma unroll
                for (int bj = 0; bj < 2; ++bj) st16(rowp + bj * HALF, pack8(acc[ai][bj][m][0], acc[ai][bj][m][1])); }
    }
};
struct SplitOrder {
    int nU, nN, G, c, t0; int tp1, tp2, tp3, tp4, tp5, tp6, tp7;
    __device__ bool next(int i, Unit& u) const {
        const int idx = i * G + c; if (idx >= nU) return false;
        const int tl = idx / SPLIT_S, s = idx - tl * SPLIT_S, pm = t0 + tl / nN, pn = tl % nN;
        const int e = (pm >= tp1) + (pm >= tp2) + (pm >= tp3) + (pm >= tp4) + (pm >= tp5) + (pm >= tp6) + (pm >= tp7);
        u.pm = pm; u.pn = e * nN + pn; u.kb = s * SPLIT_KB; return true;
    }
    __device__ __forceinline__ void a_ready(const Unit&) const {}
    __device__ __forceinline__ void done(const Unit&) const {}
};
struct TileOrder {
    int nM, nN, nwg, G, c, t0; int tp1, tp2, tp3, tp4, tp5, tp6, tp7; bool grouped;
    __device__ void init(int nM_, int nN_, int G_, int c_, int t0_) { nM = nM_; nN = nN_; nwg = nM * nN; G = G_; c = c_; t0 = t0_; grouped = false; tp1 = tp2 = tp3 = tp4 = tp5 = tp6 = tp7 = 0; }
    __device__ bool next(int i, Unit& u) const {
        const long L = (long)i * G + c; if (L >= nwg) return false;
        int wgid = (int)L; { const int q = nwg / NXCD, r = nwg % NXCD, xcd = wgid % NXCD, off = wgid / NXCD; wgid = (xcd < r ? xcd * (q + 1) : r * (q + 1) + (xcd - r) * q) + off; }
        const int nig = WGM * nN, gid = wgid / nig, fm = gid * WGM, gsz = (nM - fm) < WGM ? (nM - fm) : WGM;
        const int pm = t0 + fm + ((wgid % nig) % gsz), pn = (wgid % nig) / gsz;
        u.pm = pm; u.pn = pn;
        if (grouped) { const int e = (pm >= tp1) + (pm >= tp2) + (pm >= tp3) + (pm >= tp4) + (pm >= tp5) + (pm >= tp6) + (pm >= tp7); u.pn = e * nN + pn; }
        return true;
    }
    __device__ __forceinline__ void a_ready(const Unit&) const {}
    __device__ __forceinline__ void done(const Unit&) const {}
};
template <class Epi, class Sched, bool ALIGN_EPI = false, bool SP2 = false, int QM = 0>
__device__ __forceinline__ void gemm_phase(PG8_LAS unsigned char* lds, const Gemm g, const Sched& S, const Epi& E) {
    const int tid = threadIdx.x, wid = __builtin_amdgcn_readfirstlane(tid >> 6), lane = tid & 63, wr = wid >> 2, wc = wid & 3, fr = lane & 15, fq = lane >> 4;
    int K_ = g.K; asm volatile("" : "+s"(K_));
    const int K = K_, nt = K / (QM ? 2 * BK : BK), RB = g.rb ? g.rb : (QM ? K : 2 * K);
    unsigned voffA[2], voffB[2];
#pragma unroll
    for (int i = 0; i < 2; ++i) { int R, C; stage_rc(tid * 16 + i * 8192, R, C); const int Rb = Epi::PERM ? ((R & ~31) + perm32(R & 31)) : R;
        voffA[i] = (unsigned)(R * RB + C * 2); voffB[i] = (unsigned)(Rb * RB + C * 2); }
    const size_t kstep = (size_t)(BK * 2);
    const size_t hstep = (size_t)HALF * RB;
    const size_t tstep = 2 * hstep;
    const unsigned ldsw = (unsigned)wid * 1024u;
    const int aoff = lds_byte(wr * 64 + fr, fq * 8), boff = lds_byte(wc * 32 + fr, fq * 8);
#define PG8_SA(b, h) (((b) * 2 + (h)) * HTB)
#define PG8_SB(b, h) ((4 + (b) * 2 + (h)) * HTB)
#define PG8_STAGE(bufoff, gbase, voff) do { _Pragma("unroll") for (int _i = 0; _i < 2; ++_i) \
        __builtin_amdgcn_global_load_lds((const unsigned*)((const char*)(gbase) + (voff)[_i]), (PG8_LAS unsigned*)(lds + (bufoff) + ldsw + _i * 8192), 16, 0, 0); } while (0)
#define PG8_LDA(dst, b, h) do { if constexpr (QM == 1) { _Pragma("unroll") for (int m = 0; m < 4; ++m) dst##8[m] = __builtin_shufflevector(*(const PG8_LAS v4i_t*)(lds + PG8_SA(b, h) + aoff + m * 2048), *(const PG8_LAS v4i_t*)(lds + PG8_SA(b, h) + aoff + m * 2048 + 1024), 0, 1, 2, 3, 4, 5, 6, 7); } \
        else { _Pragma("unroll") for (int m = 0; m < 4; ++m) _Pragma("unroll") for (int k = 0; k < 2; ++k) dst[m][k] = *(const PG8_LAS bf16x8*)(lds + PG8_SA(b, h) + aoff + m * 2048 + k * 1024); } } while (0)
#define PG8_LDB(dst, b, h) do { if constexpr (QM == 1) { _Pragma("unroll") for (int n = 0; n < 2; ++n) dst##8[n] = __builtin_shufflevector(*(const PG8_LAS v4i_t*)(lds + PG8_SB(b, h) + boff + n * 2048), *(const PG8_LAS v4i_t*)(lds + PG8_SB(b, h) + boff + n * 2048 + 1024), 0, 1, 2, 3, 4, 5, 6, 7); } \
        else { _Pragma("unroll") for (int n = 0; n < 2; ++n) _Pragma("unroll") for (int k = 0; k < 2; ++k) dst[n][k] = *(const PG8_LAS bf16x8*)(lds + PG8_SB(b, h) + boff + n * 2048 + k * 1024); } } while (0)
#define PG8_MMA(ai, bj, At, Bt) do { __builtin_amdgcn_s_setprio(1); \
        if constexpr (QM == 2) { _Pragma("unroll") for (int m = 0; m < 4; ++m) _Pragma("unroll") for (int n = 0; n < 2; ++n) _Pragma("unroll") for (int k = 0; k < 2; ++k) \
            acc[ai][bj][m][n] = __builtin_bit_cast(f32x4, __builtin_amdgcn_mfma_i32_16x16x64_i8(__builtin_bit_cast(v4i_t, Bt[n][k]), __builtin_bit_cast(v4i_t, At[m][k]), __builtin_bit_cast(v4i_t, acc[ai][bj][m][n]), 0, 0, 0)); } \
        else if constexpr (QM == 1) { _Pragma("unroll") for (int m = 0; m < 4; ++m) _Pragma("unroll") for (int n = 0; n < 2; ++n) \
            asm volatile("v_mfma_scale_f32_16x16x128_f8f6f4 %0, %1, %2, %0, %3, %4 op_sel_hi:[0,0,0]" : "+v"(acc[ai][bj][m][n]) : "v"(Bt##8[n]), "v"(At##8[m]), "v"(vsb), "v"(vsa)); } \
        else { _Pragma("unroll") for (int m = 0; m < 4; ++m) _Pragma("unroll") for (int n = 0; n < 2; ++n) _Pragma("unroll") for (int k = 0; k < 2; ++k) \
            acc[ai][bj][m][n] = __builtin_amdgcn_mfma_f32_16x16x32_bf16(Bt[n][k], At[m][k], acc[ai][bj][m][n], 0, 0, 0); } \
        __builtin_amdgcn_s_setprio(0); } while (0)
#define PG8_WAIT_V(n) asm volatile("s_waitcnt vmcnt(" #n ")" ::: "memory")
#define PG8_WAIT_L(n) asm volatile("s_waitcnt lgkmcnt(" #n ")" ::: "memory")
#define PG8_BAR __builtin_amdgcn_s_barrier()
#define PG8_SCHED __builtin_amdgcn_sched_barrier(0)
#define PG8_WAIT_VR() asm volatile("s_cmp_eq_u32 %0, 0\n\ts_cbranch_scc1 2\n\ts_waitcnt vmcnt(%1)\n\ts_branch 1\n\ts_waitcnt vmcnt(8)" :: "s"(relax), "n"(8 + Epi::NSTORE) : "memory", "scc")
    int vsa = g.sa, vsb = g.sb; if constexpr (QM == 1) { asm volatile("" : "+v"(vsa), "+v"(vsb)); }
    Unit cur, nxt; cur.kb = 0; nxt.kb = 0; int ui = 0;
    if (!S.next(0, cur)) return;
    f32x4 acc[2][2][4][2];
#pragma unroll
    for (int a = 0; a < 2; ++a)
#pragma unroll
        for (int b = 0; b < 2; ++b)
#pragma unroll
            for (int m = 0; m < 4; ++m)
#pragma unroll
                for (int n = 0; n < 2; ++n) acc[a][b][m][n] = (f32x4){0.f, 0.f, 0.f, 0.f};
    bf16x8 At[4][2], B0[2][2], B1[2][2]; v8i_t At8[4], B08[2], B18[2];
    const char* cA = (const char*)g.A + (size_t)cur.pm * tstep + cur.kb; const char* cB = (const char*)g.Bt + (size_t)cur.pn * tstep + cur.kb;
    S.a_ready(cur);
    if constexpr (SP2) {
        PG8_STAGE(PG8_SB(0, 0), cB, voffB); PG8_STAGE(PG8_SB(0, 1), cB + hstep, voffB); PG8_STAGE(PG8_SA(0, 0), cA, voffA); PG8_STAGE(PG8_SA(0, 1), cA + hstep, voffA);
        if (wr == 1) PG8_BAR;
        PG8_WAIT_V(2); PG8_BAR;
        PG8_STAGE(PG8_SB(1, 0), cB + kstep, voffB); PG8_STAGE(PG8_SA(1, 0), cA + kstep, voffA); PG8_STAGE(PG8_SB(1, 1), cB + hstep + kstep, voffB);
        PG8_WAIT_V(6); PG8_BAR;
    } else {
        PG8_STAGE(PG8_SB(0, 0), cB, voffB); PG8_STAGE(PG8_SA(0, 0), cA, voffA); PG8_STAGE(PG8_SB(0, 1), cB + hstep, voffB); PG8_STAGE(PG8_SA(0, 1), cA + hstep, voffA);
        if (wr == 1) PG8_BAR;
        PG8_WAIT_V(4); PG8_BAR;
        PG8_STAGE(PG8_SB(1, 0), cB + kstep, voffB); PG8_STAGE(PG8_SA(1, 0), cA + kstep, voffA); PG8_STAGE(PG8_SB(1, 1), cB + hstep + kstep, voffB);
        PG8_WAIT_V(6); PG8_BAR;
    }
    for (;;) {
        const bool has_next = S.next(ui + 1, nxt);
        const char* nA = has_next ? (const char*)g.A + (size_t)nxt.pm * tstep + nxt.kb : cA; const char* nB = has_next ? (const char*)g.Bt + (size_t)nxt.pn * tstep + nxt.kb : cB;
        for (int t = 0; t < nt; t += 2) {
            const bool last = (t == nt - 2);
            const char* a1 = cA + (size_t)(t + 1) * kstep;
            const char* a2 = last ? nA : cA + (size_t)(t + 2) * kstep; const char* b2 = last ? nB : cB + (size_t)(t + 2) * kstep;
            const char* a3 = a2 + kstep; const char* b3 = b2 + kstep;
            if (last && has_next) S.a_ready(nxt);
            if constexpr (SP2) {
            const int relax = __builtin_amdgcn_readfirstlane((t == 0 && ui > 0) ? 1 : 0);
            PG8_LDB(B0, 0, 0); PG8_LDB(B1, 0, 1); PG8_SCHED; PG8_LDA(At, 0, 0); PG8_STAGE(PG8_SA(1, 1), a1 + hstep, voffA);
            PG8_WAIT_VR(); PG8_WAIT_L(0); PG8_BAR; PG8_MMA(0, 0, At, B0); PG8_MMA(0, 1, At, B1); PG8_BAR; PG8_SCHED;
            PG8_LDA(At, 0, 1); PG8_STAGE(PG8_SB(0, 0), b2, voffB); PG8_STAGE(PG8_SB(0, 1), b2 + hstep, voffB); PG8_STAGE(PG8_SA(0, 0), a2, voffA);
            PG8_WAIT_VR(); PG8_WAIT_L(0); PG8_BAR; PG8_MMA(1, 0, At, B0); PG8_MMA(1, 1, At, B1); PG8_BAR; PG8_SCHED;
            PG8_LDB(B0, 1, 0); PG8_LDB(B1, 1, 1); PG8_SCHED; PG8_LDA(At, 1, 0); PG8_STAGE(PG8_SA(0, 1), a2 + hstep, voffA);
            PG8_WAIT_V(8); PG8_WAIT_L(0); PG8_BAR; PG8_MMA(0, 0, At, B0); PG8_MMA(0, 1, At, B1); PG8_BAR; PG8_SCHED;
            PG8_LDA(At, 1, 1); PG8_STAGE(PG8_SB(1, 0), b3, voffB); PG8_STAGE(PG8_SB(1, 1), b3 + hstep, voffB); PG8_STAGE(PG8_SA(1, 0), a3, voffA);
            PG8_WAIT_V(8); PG8_WAIT_L(0); PG8_BAR; PG8_MMA(1, 0, At, B0); PG8_MMA(1, 1, At, B1); PG8_BAR; PG8_SCHED;
            } else {
            PG8_LDB(B0, 0, 0); PG8_SCHED; PG8_LDA(At, 0, 0); PG8_STAGE(PG8_SA(1, 1), a1 + hstep, voffA);
            PG8_WAIT_L(8); PG8_BAR; PG8_WAIT_L(0); PG8_MMA(0, 0, At, B0); PG8_BAR; PG8_SCHED;
            PG8_LDB(B1, 0, 1); PG8_STAGE(PG8_SB(0, 0), b2, voffB);
            PG8_BAR; PG8_WAIT_L(0); PG8_MMA(0, 1, At, B1); PG8_BAR;
            PG8_LDA(At, 0, 1); PG8_STAGE(PG8_SA(0, 0), a2, voffA);
            PG8_BAR; PG8_WAIT_L(0); PG8_MMA(1, 0, At, B0); PG8_BAR; PG8_SCHED;
            PG8_STAGE(PG8_SB(0, 1), b2 + hstep, voffB);
            PG8_WAIT_V(6); PG8_BAR; PG8_MMA(1, 1, At, B1); PG8_BAR;
            PG8_LDB(B0, 1, 0); PG8_SCHED; PG8_LDA(At, 1, 0); PG8_STAGE(PG8_SA(0, 1), a2 + hstep, voffA);
            PG8_WAIT_L(8); PG8_BAR; PG8_WAIT_L(0); PG8_MMA(0, 0, At, B0); PG8_BAR; PG8_SCHED;
            PG8_LDB(B1, 1, 1); PG8_STAGE(PG8_SB(1, 0), b3, voffB);
            PG8_BAR; PG8_WAIT_L(0); PG8_MMA(0, 1, At, B1); PG8_BAR;
            PG8_LDA(At, 1, 1); PG8_STAGE(PG8_SA(1, 0), a3, voffA);
            PG8_BAR; PG8_WAIT_L(0); PG8_MMA(1, 0, At, B0); PG8_BAR; PG8_SCHED;
            PG8_STAGE(PG8_SB(1, 1), b3 + hstep, voffB);
            PG8_WAIT_V(6); PG8_BAR; PG8_MMA(1, 1, At, B1); PG8_BAR;
            }
        }
        if constexpr (QM == 1) { asm volatile("s_nop 15\n\ts_nop 15\n\ts_nop 7" ::: "memory"); }
        if constexpr (ALIGN_EPI) { if (wr == 0) PG8_BAR; }
        if constexpr (!Epi::AFTER_DRAIN) { E(acc, cur, wr, wc, fr, fq); S.done(cur); }
        if (!has_next) break;
#pragma unroll
        for (int a = 0; a < 2; ++a)
#pragma unroll
            for (int b = 0; b < 2; ++b)
#pragma unroll
                for (int m = 0; m < 4; ++m)
#pragma unroll
                    for (int n = 0; n < 2; ++n) acc[a][b][m][n] = (f32x4){0.f, 0.f, 0.f, 0.f};
        cur = nxt; cA = nA; cB = nB; ++ui;
        if constexpr (ALIGN_EPI) { if (wr == 1) PG8_BAR; }
    }
    PG8_WAIT_V(0);
    if constexpr (!ALIGN_EPI) { if (wr == 0) PG8_BAR; }
    PG8_BAR;
    if constexpr (Epi::AFTER_DRAIN) { E.fused(acc, cur, wr, wc, fr, fq, lds, wid, lane); S.done(cur); }
#undef PG8_SA
#undef PG8_SB
#undef PG8_STAGE
#undef PG8_LDA
#undef PG8_LDB
#undef PG8_MMA
#undef PG8_WAIT_V
#undef PG8_WAIT_L
#undef PG8_BAR
#undef PG8_SCHED
#undef PG8_WAIT_VR
}
}

constexpr int NT = 16384, DM = 1024, SEQ = 4096;
constexpr int NWAVES = 8, NTHR = 512;
constexpr float NORM_EPS = 1e-6f;
constexpr size_t MiB = 1u << 20;
constexpr size_t WS_CTL = 0, CTL_ZERO_BYTES = 1 * MiB;
constexpr size_t WS_RSS = 128 * 1024;
constexpr size_t WS_ROPE = 1 * MiB;
constexpr size_t WS_SSM_B = WS_ROPE + 512 * 1024;
constexpr size_t WS_SSM_C = WS_SSM_B + 128 * 1024;
constexpr size_t WS_SSM_L = WS_SSM_C + 128 * 1024;
constexpr size_t WS_RSTDQ = 2 * MiB;
constexpr size_t WS_RSTDKV = WS_RSTDQ + 64 * 1024;
constexpr size_t WS_TOKE = WS_RSTDKV + 64 * 1024;
constexpr size_t WS_TOKW = WS_TOKE + 128 * 1024;
constexpr size_t WS_TOKR = WS_TOKW + 128 * 1024;
constexpr size_t WS_BCNT = WS_TOKR + 128 * 1024;
constexpr size_t WS_META = WS_BCNT + 8 * 1024;
constexpr size_t WS_SB = WS_BCNT + 16 * 1024;
constexpr size_t WS_SB0 = WS_SB + 32 * 1024, WS_SB1 = WS_SB + 40 * 1024;
constexpr size_t WS_SA = WS_RSTDKV;
constexpr size_t WS_WIN0 = 8 * MiB;
constexpr size_t WS_WGLU = WS_WIN0 + 3 * MiB;
constexpr size_t WS_WOUT0 = WS_WGLU + MiB / 2;
constexpr size_t WS_WGU0 = WS_WOUT0 + 2 * MiB;
constexpr size_t WS_WDN0 = WS_WGU0 + 16 * MiB;
constexpr size_t WS_WIN1 = WS_WDN0 + 8 * MiB;
constexpr size_t WS_WUQ = WS_WIN1 + 3 * MiB;
constexpr size_t WS_WUKV = WS_WUQ + 384 * 1024;
constexpr size_t WS_WOUT1 = WS_WUKV + MiB / 2;
constexpr size_t WS_WGU1 = WS_WOUT1 + 2 * MiB;
constexpr size_t WS_WDN1 = WS_WGU1 + 56 * MiB;
constexpr size_t WS_H = WS_WDN1 + 28 * MiB;
constexpr size_t WS_Z = WS_H + 64 * MiB;
constexpr size_t WS_MIX = WS_Z + 32 * MiB;
constexpr size_t WS_T = WS_MIX + 32 * MiB;
constexpr size_t WS_USSM = WS_T, WS_GU = WS_T + 16 * MiB, WS_GV = WS_T + 32 * MiB, WS_YB = WS_T + 48 * MiB, WS_MIXCAT0 = WS_T + 64 * MiB;
constexpr size_t WS_HFF = WS_T;
constexpr size_t WS_HGLU = WS_T, WS_CQ = WS_T + 16 * MiB, WS_CKV = WS_T + 24 * MiB, WS_Q = WS_T + 32 * MiB, WS_KK = WS_T + 56 * MiB, WS_VV = WS_T + 80 * MiB, WS_MIXCAT1 = WS_T + 96 * MiB;
constexpr int MOE_MAX_ROWS = 34816;
constexpr size_t WS_HOUT = WS_Z;
constexpr size_t WS_AG8 = WS_Z + 64 * MiB;
constexpr size_t WS_HMOE8 = WS_AG8 + 34 * MiB;
constexpr size_t WS_PART = WS_WIN0;
constexpr size_t WS_END = WS_HMOE8 + 119 * MiB;
static_assert(WS_PART + (size_t)7 * 8 * 256 * 1024 * 2 <= WS_WGU1, "split-K partials");
static_assert(WS_HOUT + (size_t)MOE_MAX_ROWS * 1024 * 2 <= WS_HMOE8 && WS_AG8 + (size_t)MOE_MAX_ROWS * 1024 <= WS_HMOE8 && WS_AG8 >= WS_MIX + 32 * MiB, "moe buffers");
static_assert(WS_END >= WS_T + 128 * MiB && WS_END <= (size_t)470 * MiB, "workspace budget");
static_assert(WS_GV - WS_GU == WS_GU - WS_USSM, "EpiIn0 destinations equally spaced");
constexpr int CW_BAR = 4096;
constexpr int LDS_BYTES = 147456;
constexpr int MISC_OFF = LDS_BYTES - 512;

#define GAS __attribute__((address_space(1)))
#define LAS __attribute__((address_space(3)))
typedef unsigned short bf16;
typedef unsigned v4u __attribute__((ext_vector_type(4)));
typedef unsigned v2u __attribute__((ext_vector_type(2)));
typedef float f32x4 __attribute__((ext_vector_type(4)));
typedef short bf16x8 __attribute__((ext_vector_type(8)));
#ifndef PROBE_SEL
#define PROBE_SEL -1
#endif
#ifndef PROBE_BLK
#define PROBE_BLK 0
#endif
#ifndef PROBE_KIND
#define PROBE_KIND 0
#endif
#ifndef PROBE_SCALE
#define PROBE_SCALE 4
#endif
constexpr int CW_PROBE = 200000;
#define PBS(k) unsigned long long pbs_t0_##k = 0; do { if (PROBE_SEL == (k)) { __syncthreads(); pbs_t0_##k = wall_clock64(); } } while (0)
#define PBE(k) do { if (PROBE_SEL == (k)) { __syncthreads(); if ((int)blockIdx.x == PROBE_BLK && threadIdx.x == 0) ((unsigned*)(a.ws + WS_CTL))[CW_PROBE] = (unsigned)(wall_clock64() - pbs_t0_##k); } } while (0)
#define LDS_WAIT() asm volatile("s_waitcnt lgkmcnt(0)" ::: "memory")
#define VM_WAIT() asm volatile("s_waitcnt vmcnt(0)" ::: "memory")
using pg8::cvt_pk_bf16; using pg8::bf_lo; using pg8::bf_hi; using pg8::sigmoid_f; using pg8::gelu_f; using pg8::silu_f;
#define XB_TMO      128
#define XB_XCNT(j)  (256  + 64 * (j))
#define XB_XSUB(j)  (1280 + 64 * (j))
#define XB_XGEN(j)  (2304 + 64 * (j))
#define XB_TOP      3328
#define XB_TOPGEN   3392
#define XCD_BAR_WORDS 3456
#define XB_SPIN_CAP (1u << 18)

__device__ __forceinline__ unsigned xb_ld(unsigned* p)              { return __hip_atomic_load(p, __ATOMIC_RELAXED, __HIP_MEMORY_SCOPE_AGENT); }
__device__ __forceinline__ unsigned xb_add(unsigned* p, unsigned v) { return __hip_atomic_fetch_add(p, v, __ATOMIC_RELAXED, __HIP_MEMORY_SCOPE_AGENT); }
__device__ __forceinline__ unsigned xb_xcc_id() { return (unsigned)__builtin_amdgcn_s_getreg((3 << 11) | 20) & 0xFu; }
#define XB_SPIN(cond, bar) do { unsigned _sp = 0; while (cond) { __builtin_amdgcn_s_sleep(1); \
    if ((++_sp & 255u) == 0u) { if (xb_ld(&(bar)[XB_TMO])) break; if (_sp > XB_SPIN_CAP) { atomicAdd(&(bar)[XB_TMO], 1u); break; } } } } while (0)

struct XcdBarrier {
    unsigned* bar; unsigned x;
    volatile LAS unsigned* st;
};

__device__ __forceinline__ XcdBarrier xcd_barrier_post(unsigned* bar, volatile LAS unsigned* st) {
    XcdBarrier b; b.bar = bar; b.x = xb_xcc_id(); b.st = st;
    if (threadIdx.x == 0) (void)xb_add(&bar[XB_XCNT(b.x)], 1u);
    return b;
}
__device__ __forceinline__ void xcd_barrier_complete(unsigned* bar, unsigned x, unsigned& nloc, unsigned& nx) {
    const unsigned G = gridDim.x * gridDim.y * gridDim.z;
    unsigned sum, cnt, mine, sp = 0u;
    for (;;) {
        sum = 0u; cnt = 0u; mine = 0u;
#pragma unroll
        for (unsigned j = 0; j < 16; ++j) { const unsigned c = xb_ld(&bar[XB_XCNT(j)]); sum += c; cnt += (c > 0u) ? 1u : 0u; mine = (j == x) ? c : mine; }
        if (sum == G) break;
        __builtin_amdgcn_s_sleep(1);
        if ((++sp & 255u) == 0u) { if (xb_ld(&bar[XB_TMO])) break; if (sp > XB_SPIN_CAP) { atomicAdd(&bar[XB_TMO], 1u); break; } }
    }
    nloc = mine > 0u ? mine : 1u; nx = cnt > 0u ? cnt : 1u;
}

__device__ __forceinline__ void xcd_barrier(const XcdBarrier& b) {
    asm volatile("s_waitcnt vmcnt(0)" ::: "memory");
    __syncthreads();
    if (threadIdx.x == 0) {
        unsigned* bar = b.bar;
        __builtin_amdgcn_s_waitcnt(0);
        unsigned nloc = b.st[0], nx = b.st[1];
        if (nloc == 0u) { xcd_barrier_complete(bar, b.x, nloc, nx); b.st[0] = nloc; b.st[1] = nx; }
        const unsigned old = xb_add(&bar[XB_XSUB(b.x)], 1u);
        const unsigned gen = old / nloc;
        if (old + 1u == (gen + 1u) * nloc) {
            __builtin_amdgcn_fence(__ATOMIC_RELEASE, "agent");
            asm volatile("s_waitcnt vmcnt(0)" ::: "memory");
            const unsigned og = xb_add(&bar[XB_TOP], 1u);
            const unsigned tg = og / nx;
            if (og + 1u == (tg + 1u) * nx) xb_add(&bar[XB_TOPGEN], 1u);
            else XB_SPIN(xb_ld(&bar[XB_TOPGEN]) == tg, bar);
            __builtin_amdgcn_fence(__ATOMIC_ACQUIRE, "agent");
            xb_add(&bar[XB_XGEN(b.x)], 1u);
            asm volatile("s_waitcnt vmcnt(0)" ::: "memory");
        } else {
            XB_SPIN(xb_ld(&bar[XB_XGEN(b.x)]) == gen, bar);
            __builtin_amdgcn_fence(__ATOMIC_ACQUIRE, "agent");
            asm volatile("s_waitcnt vmcnt(0)" ::: "memory");
        }
    }
    __syncthreads();
}

struct TDesc { const float* W; bf16* WT; const float* gain; long sstride, dstride; int ldw, K, N, Kd, map, roff, nb, item0; float scale; int fp8; };
constexpr int ND = 15, ND_P0 = 12, MOE_ITEMS = 3 * 14336;
constexpr int MQ_LO_A = 2816, MQ_LO_B = 0, MQ_LO_C = 0, MQ_LO_D = 1024;
constexpr int MQ_A = 10752, MQ_B = MQ_A + 14848, MQ_C = MQ_B + 6656, MQ_D = MOE_ITEMS - 2048, MQ_E = MOE_ITEMS, MQ_SLOTS = MQ_E;
struct Args {
    const float* in[34]; float* out; unsigned char* ws;
    TDesc td[ND]; int n_items; int ph_lo, ph_hi, dbg;
};
struct Frame {
    LAS unsigned char* lds; volatile LAS unsigned* MISC; unsigned* ctl;
    int tid, lane, wave, vcu, G;
};
#define WAVE_DPP(OLD, V, CTRL, RM) __builtin_bit_cast(float, __builtin_amdgcn_update_dpp(__builtin_bit_cast(int, (float)(OLD)), __builtin_bit_cast(int, (float)(V)), (CTRL), (RM), 0xF, false))
__device__ __forceinline__ float wave_sum(float v) {
    v += WAVE_DPP(0.f, v, 0xB1, 0xF); v += WAVE_DPP(0.f, v, 0x4E, 0xF); v += WAVE_DPP(0.f, v, 0x141, 0xF); v += WAVE_DPP(0.f, v, 0x140, 0xF);
    v += WAVE_DPP(0.f, v, 0x142, 0xA); v += WAVE_DPP(0.f, v, 0x143, 0xC);
    return __builtin_bit_cast(float, __builtin_amdgcn_readlane(__builtin_bit_cast(int, v), 63));
}
__device__ __forceinline__ unsigned pk2(float lo, float hi) { return cvt_pk_bf16(lo, hi); }
__device__ __forceinline__ float wave_max(float v) {
    v = fmaxf(v, WAVE_DPP(v, v, 0xB1, 0xF)); v = fmaxf(v, WAVE_DPP(v, v, 0x4E, 0xF)); v = fmaxf(v, WAVE_DPP(v, v, 0x141, 0xF)); v = fmaxf(v, WAVE_DPP(v, v, 0x140, 0xF));
    v = fmaxf(v, WAVE_DPP(v, v, 0x142, 0xA)); v = fmaxf(v, WAVE_DPP(v, v, 0x143, 0xC));
    return __builtin_bit_cast(float, __builtin_amdgcn_readlane(__builtin_bit_cast(int, v), 63));
}

struct P0Regs { f32x4 v[8]; float g[8]; };
__device__ __forceinline__ void p0_item_load(const TDesc& d, int item, int lane, P0Regs& R) {
    const int nblk = d.N / 32, ipb = (d.K / 64) * nblk, e = item / ipb, r = item - e * ipb, kb = r / nblk, nb = r - kb * nblk, k0 = 64 * kb, n0 = 32 * nb;
    const int lr = lane >> 3, lc = 4 * (lane & 7);
    const float* wp = d.W + (size_t)e * d.sstride + (size_t)(k0 + lr) * d.ldw + n0 + lc;
#pragma unroll
    for (int i = 0; i < 8; ++i) R.v[i] = __builtin_nontemporal_load((const f32x4*)(wp + (size_t)(8 * i) * d.ldw));
#pragma unroll
    for (int i = 0; i < 8; ++i) R.g[i] = (d.gain ? d.gain[k0 + lr + 8 * i] : 1.0f) * d.scale;
}
__device__ __forceinline__ void p0_item_store(const TDesc& d, LAS float* scr, int item, int lane, const P0Regs& R) {
    const int nblk = d.N / 32, ipb = (d.K / 64) * nblk, e = item / ipb, r = item - e * ipb, kb = r / nblk, nb = r - kb * nblk, k0 = 64 * kb, n0 = 32 * nb;
    bf16* WT = d.WT + (size_t)e * d.dstride;
    const int drow0 = d.roff + (d.map == 0 ? n0 : ((n0 >> 7) * 256 + (n0 & 127) + (d.map == 2 ? 128 : 0)));
    const int lr = lane >> 3, lc = 4 * (lane & 7);
#pragma unroll
    for (int i = 0; i < 8; ++i) { LAS float* s = scr + (lr + 8 * i) * 33 + lc; s[0] = R.v[i].x * R.g[i]; s[1] = R.v[i].y * R.g[i]; s[2] = R.v[i].z * R.g[i]; s[3] = R.v[i].w * R.g[i]; }
    LDS_WAIT(); asm volatile("" ::: "memory");
    if (d.fp8) { unsigned char* W8 = (unsigned char*)d.WT + (size_t)e * d.dstride; const int c = lane & 3;
#pragma unroll
        for (int j = 0; j < 2; ++j) { const int n = (lane >> 2) + 16 * j; const LAS float* s = scr + (16 * c) * 33 + n;
            v4u o; o.x = pg8::pk4_fp8(s[0 * 33], s[1 * 33], s[2 * 33], s[3 * 33]); o.y = pg8::pk4_fp8(s[4 * 33], s[5 * 33], s[6 * 33], s[7 * 33]);
            o.z = pg8::pk4_fp8(s[8 * 33], s[9 * 33], s[10 * 33], s[11 * 33]); o.w = pg8::pk4_fp8(s[12 * 33], s[13 * 33], s[14 * 33], s[15 * 33]);
            *(v4u*)(W8 + (size_t)(drow0 + n) * d.Kd + k0 + 16 * c) = o; }
    } else { const int c = lane & 7;
#pragma unroll
    for (int j = 0; j < 4; ++j) { const int n = (lane >> 3) + 8 * j; const LAS float* s = scr + (8 * c) * 33 + n;
        v4u o; o.x = pk2(s[0 * 33], s[1 * 33]); o.y = pk2(s[2 * 33], s[3 * 33]); o.z = pk2(s[4 * 33], s[5 * 33]); o.w = pk2(s[6 * 33], s[7 * 33]);
        *(v4u*)(WT + (size_t)(drow0 + n) * d.Kd + k0 + 8 * c) = o; } }
    LDS_WAIT(); asm volatile("" ::: "memory");
}
__device__ __forceinline__ void rms_row_to_bf16(const float* xrow, bf16* orow, int lane) {
    const f32x4* xr = (const f32x4*)xrow + lane; f32x4 v[4]; float s = 0.f;
#pragma unroll
    for (int j = 0; j < 4; ++j) { v[j] = xr[64 * j]; s += (v[j].x * v[j].x + v[j].y * v[j].y) + (v[j].z * v[j].z + v[j].w * v[j].w); }
    const float rstd = 1.0f / sqrtf(wave_sum(s) * (1.f / DM) + NORM_EPS);
    v2u* o8 = (v2u*)orow + lane;
#pragma unroll
    for (int j = 0; j < 4; ++j) { v2u w; w.x = pk2(v[j].x * rstd, v[j].y * rstd); w.y = pk2(v[j].z * rstd, v[j].w * rstd); o8[64 * j] = w; }
}
__device__ __forceinline__ unsigned pk4_i8(float a, float b, float c, float d) { return ((unsigned)(int)__builtin_rintf(a) & 255u) | (((unsigned)(int)__builtin_rintf(b) & 255u) << 8) | (((unsigned)(int)__builtin_rintf(c) & 255u) << 16) | ((unsigned)(int)__builtin_rintf(d) << 24); }
__device__ __forceinline__ void p0_i8_block(const TDesc& d, Frame& F, int cb, float* sB) {
    const int lane = F.lane, w = F.wave, col0 = 64 * cb, half = w & 1, n0 = col0 + 32 * half; const bool act = n0 < d.N;
    LAS float* cmx = (LAS float*)(F.lds + 8 * 16384);
    LAS float* inv = cmx + 512; LAS float* gl = cmx + 1024;
    LAS float* scr = (LAS float*)(F.lds + w * 16384);
    const int lr = lane >> 3, lc = 4 * (lane & 7);
    const float* wp = d.W + (size_t)(64 * (w >> 1) + lr) * d.ldw + (act ? n0 : 0) + lc; const size_t ks = (size_t)256 * d.ldw, rs = (size_t)8 * d.ldw;
    f32x4 va[8], vb[8];
#define I8_LOAD(V, S) do { _Pragma("unroll") for (int i = 0; i < 8; ++i) V[i] = *(const f32x4*)(wp + (S) * ks + i * rs); } while (0)
    I8_LOAD(va, 0); I8_LOAD(vb, 1);
    { const float gv0 = d.gain ? d.gain[F.tid] : 1.0f, gv1 = d.gain ? d.gain[F.tid + 512] : 1.0f; gl[F.tid] = gv0; gl[F.tid + 512] = gv1; }
    __syncthreads();
    f32x4 mx = {0.f, 0.f, 0.f, 0.f};
#define I8_MAX(V, S) do { _Pragma("unroll") for (int i = 0; i < 8; ++i) mx = __builtin_elementwise_max(mx, __builtin_elementwise_abs(V[i] * gl[64 * ((w >> 1) + 4 * (S)) + lr + 8 * i])); } while (0)
    I8_MAX(va, 0); I8_LOAD(va, 2); I8_MAX(vb, 1); I8_LOAD(vb, 3); I8_MAX(va, 2); I8_LOAD(va, 0); I8_MAX(vb, 3); I8_LOAD(vb, 1);
#undef I8_MAX
#pragma unroll
    for (int o = 8; o < 64; o <<= 1) { mx.x = fmaxf(mx.x, __shfl_xor(mx.x, o)); mx.y = fmaxf(mx.y, __shfl_xor(mx.y, o)); mx.z = fmaxf(mx.z, __shfl_xor(mx.z, o)); mx.w = fmaxf(mx.w, __shfl_xor(mx.w, o)); }
    if (lr == 0) { LAS float* c = cmx + w * 32 + lc; const float z = act ? 1.f : 0.f; c[0] = mx.x * z; c[1] = mx.y * z; c[2] = mx.z * z; c[3] = mx.w * z; }
    __syncthreads();
    if (w == 0) { const int hh = lane >> 5, cc = lane & 31; float m1 = 1e-30f;
#pragma unroll
        for (int k = 0; k < 4; ++k) m1 = fmaxf(m1, cmx[(hh + 2 * k) * 32 + cc]);
        const int n = col0 + lane; const int drow = d.roff + (d.map == 0 ? n : ((n >> 7) * 256 + (n & 127) + (d.map == 2 ? 128 : 0)));
        if (n < d.N) sB[drow] = m1 * (1.0f / 127.0f); inv[lane] = 127.0f / m1; }
    __syncthreads();
    const int drow0 = d.roff + (d.map == 0 ? n0 : ((n0 >> 7) * 256 + (n0 & 127) + (d.map == 2 ? 128 : 0)));
    unsigned char* W8 = (unsigned char*)d.WT; const int c = lane & 3;
#define I8_STORE(V, S) do { const int kb_ = (w >> 1) + 4 * (S); \
        _Pragma("unroll") for (int i = 0; i < 8; ++i) { const float g_ = gl[64 * kb_ + lr + 8 * i]; LAS float* sp = scr + (lr + 8 * i) * 33 + lc; sp[0] = V[i].x * g_; sp[1] = V[i].y * g_; sp[2] = V[i].z * g_; sp[3] = V[i].w * g_; } \
        LDS_WAIT(); asm volatile("" ::: "memory"); \
        if (act) { _Pragma("unroll") for (int j = 0; j < 2; ++j) { const int n = (lane >> 2) + 16 * j; const LAS float* sp = scr + (16 * c) * 33 + n; const float iv = inv[32 * half + n]; \
            v4u o; o.x = pk4_i8(sp[0 * 33] * iv, sp[1 * 33] * iv, sp[2 * 33] * iv, sp[3 * 33] * iv); o.y = pk4_i8(sp[4 * 33] * iv, sp[5 * 33] * iv, sp[6 * 33] * iv, sp[7 * 33] * iv); \
            o.z = pk4_i8(sp[8 * 33] * iv, sp[9 * 33] * iv, sp[10 * 33] * iv, sp[11 * 33] * iv); o.w = pk4_i8(sp[12 * 33] * iv, sp[13 * 33] * iv, sp[14 * 33] * iv, sp[15 * 33] * iv); \
            *(v4u*)(W8 + (size_t)(drow0 + n) * d.Kd + 64 * kb_ + 16 * c) = o; } } \
        LDS_WAIT(); asm volatile("" ::: "memory"); } while (0)
    I8_STORE(va, 0); I8_LOAD(va, 2); I8_STORE(vb, 1); I8_LOAD(vb, 3); I8_STORE(va, 2); I8_STORE(vb, 3);
#undef I8_STORE
#undef I8_LOAD
    __syncthreads();
}
struct MoeRegs { f32x4 v[8]; };
__device__ __forceinline__ void moe_item_load(const TDesc& d, int item, bool valid, int lane, MoeRegs& R) {
    const int nblk = d.N / 32, ipb = (d.K / 64) * nblk, e = item / ipb, r = item - e * ipb, pr = r >> 1, kq = pr / nblk, nb = pr - kq * nblk, kb = 2 * kq + (r & 1), k0 = 64 * kb, n0 = 32 * nb;
    const int lr = lane >> 3, lc = 4 * (lane & 7);
    const float* wp = d.W + (size_t)e * d.sstride + (size_t)(k0 + lr) * d.ldw + n0 + lc; size_t rs = (size_t)8 * d.ldw;
    if (!valid) { wp = d.W + lc; rs = 0; }
#pragma unroll
    for (int i = 0; i < 8; ++i) R.v[i] = __builtin_nontemporal_load((const f32x4*)(wp + (size_t)i * rs));
}
__device__ __forceinline__ void moe_item_store(const TDesc& d, LAS float* scr, const LAS float* gl, int item, int lane, const MoeRegs& R) {
    const int nblk = d.N / 32, ipb = (d.K / 64) * nblk, e = item / ipb, r = item - e * ipb, pr = r >> 1, kq = pr / nblk, nb = pr - kq * nblk, kb = 2 * kq + (r & 1), k0 = 64 * kb, n0 = 32 * nb;
    const int drow0 = d.roff + (d.map == 0 ? n0 : ((n0 >> 7) * 256 + (n0 & 127) + (d.map == 2 ? 128 : 0)));
    const int lr = lane >> 3, lc = 4 * (lane & 7);
#pragma unroll
    for (int i = 0; i < 8; ++i) { const float g = gl[(k0 + lr + 8 * i) & 1023]; LAS float* s = scr + (lr + 8 * i) * 33 + lc; s[0] = R.v[i].x * g; s[1] = R.v[i].y * g; s[2] = R.v[i].z * g; s[3] = R.v[i].w * g; }
    LDS_WAIT(); asm volatile("" ::: "memory");
    unsigned char* W8 = (unsigned char*)d.WT + (size_t)e * d.dstride; const int c = lane & 3;
#pragma unroll
    for (int j = 0; j < 2; ++j) { const int n = (lane >> 2) + 16 * j; const LAS float* s = scr + (16 * c) * 33 + n;
        v4u o; o.x = pg8::pk4_fp8(s[0 * 33], s[1 * 33], s[2 * 33], s[3 * 33]); o.y = pg8::pk4_fp8(s[4 * 33], s[5 * 33], s[6 * 33], s[7 * 33]);
        o.z = pg8::pk4_fp8(s[8 * 33], s[9 * 33], s[10 * 33], s[11 * 33]); o.w = pg8::pk4_fp8(s[12 * 33], s[13 * 33], s[14 * 33], s[15 * 33]);
        __builtin_nontemporal_store(o, (v4u*)(W8 + (size_t)(drow0 + n) * d.Kd + k0 + 16 * c)); }
    LDS_WAIT(); asm volatile("" ::: "memory");
}
__device__ __forceinline__ void moe_convert_range(const Args& a, Frame& F, int m0, int m1, int iw, int NW) {
    LAS float* scr = (LAS float*)(F.lds + F.wave * 16384);
#pragma unroll
    for (int d = 12; d < 15; ++d) { const int lo = (d - 12) * 14336, hi = lo + 14336; const int b0 = m0 > lo ? m0 : lo, b1 = m1 < hi ? m1 : hi;
        const int np = (b1 - b0) >> 1, n = (b0 < b1 && iw < np) ? 2 * ((np - iw + NW - 1) / NW) : 0;
        if (n > 0) { const int base = b0 + 2 * iw - lo;
            { LAS float* gw_ = scr + 2112; const float* gp_ = a.td[d].gain; const float sc_ = a.td[d].scale;
#pragma unroll
              for (int i = 0; i < 16; ++i) gw_[F.lane + 64 * i] = (gp_ ? gp_[F.lane + 64 * i] : 1.0f) * sc_;
              LDS_WAIT(); asm volatile("" ::: "memory"); }
            const LAS float* gl = scr + 2112;
#define MC_LOAD(R, J) do { const int j_ = (J); const bool ok_ = j_ < n; moe_item_load(a.td[d], base + (ok_ ? 2 * (j_ >> 1) * NW + (j_ & 1) : 0), ok_, F.lane, R); } while (0)
#define MC_STORE(R, J) moe_item_store(a.td[d], scr, gl, base + 2 * ((J) >> 1) * NW + ((J) & 1), F.lane, R)
            MoeRegs R0, R1, R2, R3; MC_LOAD(R0, 0); MC_LOAD(R1, 1); MC_LOAD(R2, 2); MC_LOAD(R3, 3);
            __builtin_amdgcn_sched_barrier(0);
            int j = 0;
#pragma unroll 1
            for (; j + 4 <= n; j += 4) {
                MC_STORE(R0, j);     MC_LOAD(R0, j + 4); __builtin_amdgcn_sched_barrier(0);
                MC_STORE(R1, j + 1); MC_LOAD(R1, j + 5); __builtin_amdgcn_sched_barrier(0);
                MC_STORE(R2, j + 2); MC_LOAD(R2, j + 6); __builtin_amdgcn_sched_barrier(0);
                MC_STORE(R3, j + 3); MC_LOAD(R3, j + 7); __builtin_amdgcn_sched_barrier(0); }
            if (j < n) MC_STORE(R0, j);
            if (j + 1 < n) MC_STORE(R1, j + 1);
            if (j + 2 < n) MC_STORE(R2, j + 2);
#undef MC_LOAD
#undef MC_STORE
        } }
}
__device__ __forceinline__ void moe_convert_slot(const Args& a, Frame& F, int m0, int m1, int nlo) {
    if (F.G != 256) return;
    const int bx = (int)blockIdx.x, ms = m1 - nlo; int s0, s1, iw;
    if (bx >= 128) { s0 = m0; s1 = ms; iw = (bx - 128) * NWAVES + F.wave; } else { s0 = ms; s1 = m1; iw = bx * NWAVES + F.wave; }
    moe_convert_range(a, F, s0, s1, iw, 1024);
}
__device__ __forceinline__ void moe_convert_all(const Args& a, Frame& F) {
    if (F.G == 256) return;
    LAS float* scr = (LAS float*)(F.lds + F.wave * 16384); const int gw = (int)blockIdx.x * NWAVES + F.wave, NGW = F.G * NWAVES;
#pragma unroll
    for (int d = 12; d < 15; ++d) for (int it = gw; it < 14336; it += NGW) { P0Regs RA; p0_item_load(a.td[d], it, F.lane, RA); p0_item_store(a.td[d], scr, it, F.lane, RA); }
}
__device__ __forceinline__ void rms_row_to_i8(const f32x4 (&v)[4], unsigned char* orow, float* sa, int lane) {
    float s = 0.f, am = 0.f;
#pragma unroll
    for (int j = 0; j < 4; ++j) { s += (v[j].x * v[j].x + v[j].y * v[j].y) + (v[j].z * v[j].z + v[j].w * v[j].w); const f32x4 z = __builtin_elementwise_abs(v[j]); am = fmaxf(am, fmaxf(fmaxf(z.x, z.y), fmaxf(z.z, z.w))); }
    const float rstd = 1.0f / sqrtf(wave_sum(s) * (1.f / DM) + NORM_EPS); am = fmaxf(wave_max(am) * rstd, 1e-30f); const float q = rstd * (127.0f / am);
    unsigned* zo = (unsigned*)orow + lane;
#pragma unroll
    for (int j = 0; j < 4; ++j) zo[64 * j] = pk4_i8(v[j].x * q, v[j].y * q, v[j].z * q, v[j].w * q);
    if (lane == 0) *sa = am * (1.0f / 127.0f);
}
__device__ __forceinline__ void p0_prologue(const Args& a, Frame& F) {
    LAS float* scr = (LAS float*)(F.lds + F.wave * 16384);
    int gw = F.vcu * NWAVES + F.wave, NGW = F.G * NWAVES;
    const bool split = F.G == 256;
#define P0_I8_DISPATCH(cb) do { const int cb_ = (cb); \
        const int di_ = cb_ < 64 ? 3 : (cb_ < 128 ? 4 : (cb_ < 152 ? 0 : (cb_ < 160 ? 6 : (cb_ < 168 ? 7 : 8)))); \
        const int c0_ = cb_ < 64 ? 0 : (cb_ < 128 ? 64 : (cb_ < 152 ? 128 : (cb_ < 160 ? 152 : (cb_ < 168 ? 160 : 168)))); \
        const size_t so_ = cb_ < 128 ? WS_SB : (cb_ < 152 ? WS_SB0 : WS_SB1); \
        p0_i8_block(a.td[di_], F, cb_ - c0_, (float*)(a.ws + so_)); } while (0)
    constexpr int NI8 = 175;
    { PBS(100);
    if (split) { if ((int)blockIdx.x < NI8) P0_I8_DISPATCH((int)blockIdx.x); }
    else { for (int cb = (int)blockIdx.x; cb < NI8; cb += F.G) P0_I8_DISPATCH(cb); }
    PBE(100); }
#undef P0_I8_DISPATCH
    const int gw_all = gw, NGW_all = NGW;
    const bool lowb = split && (int)blockIdx.x < NI8;
    const int seg0 = (split && !lowb) ? NI8 * NWAVES : 0, seg1 = lowb ? NI8 * NWAVES : a.td[ND_P0].item0;
    gw = !split ? gw_all : (lowb ? (int)blockIdx.x * NWAVES + F.wave : NI8 * NWAVES + ((int)blockIdx.x - NI8) * NWAVES + F.wave);
    NGW = !split ? NGW_all : (lowb ? NI8 * NWAVES : (256 - NI8) * NWAVES);
    { PBS(101);
    {
#pragma unroll
    for (int d = 0; d < ND_P0; ++d) { const int lo0 = a.td[d].item0, hi0 = a.td[d + 1].item0, lo = lo0 > seg0 ? lo0 : seg0, hi = hi0 < seg1 ? hi0 : seg1;

        int it = lo + ((gw - lo) % NGW + NGW) % NGW;
        P0Regs RA, RB;
        if (it < hi) p0_item_load(a.td[d], it - lo0, F.lane, RA);
        for (; it < hi; it += 2 * NGW) {
            if (it + NGW < hi) p0_item_load(a.td[d], it + NGW - lo0, F.lane, RB);
            p0_item_store(a.td[d], scr, it - lo0, F.lane, RA);
            if (it + NGW < hi) { if (it + 2 * NGW < hi) p0_item_load(a.td[d], it + 2 * NGW - lo0, F.lane, RA);
                p0_item_store(a.td[d], scr, it + NGW - lo0, F.lane, RB); } } }
    }
    PBE(101); }
    gw = gw_all; NGW = NGW_all;
    if (F.G == 256) moe_convert_range(a, F, MQ_SLOTS, MOE_ITEMS, gw, NGW);
    unsigned char* ws = a.ws;
    const int gt = F.vcu * NTHR + F.tid, NGT = F.G * NTHR;
    PBS(102);
    { v4u z = {0u, 0u, 0u, 0u};
      v4u* p1 = (v4u*)(ws + WS_WIN1 + (size_t)1440 * 1024); for (int i = gt; i < 96 * 1024 / 16; i += NGT) p1[i] = z;
      for (int i = gt; i < 96; i += NGT) ((float*)(ws + WS_SB1))[1440 + i] = 1.0f;
      for (int i = gt; i < 1024 * 16; i += NGT) { const int r = i >> 4, c = i & 15; *(v4u*)(ws + WS_WUKV + (size_t)r * 512 + 256 + c * 16) = z; } }
    { float* cs = (float*)(ws + WS_ROPE);
      for (int i = gt; i < SEQ * 16; i += NGT) { const int t = i >> 4, j = i & 15; const float invf = __builtin_amdgcn_exp2f(-(float)j * (0.0625f * 13.287712379549449f));
          double rev = (double)((float)t * invf) * 0.15915494309189535; rev -= floor(rev); const float rf = (float)rev;
          cs[t * 32 + j] = __builtin_amdgcn_cosf(rf); cs[t * 32 + 16 + j] = __builtin_amdgcn_sinf(rf); } }
    { const float* lre = a.in[3]; const float* lim = a.in[4]; const float* ldt = a.in[5]; const float* bre = a.in[6]; const float* bim = a.in[7]; const float* cre = a.in[8]; const float* cim = a.in[9];
      bf16* BT = (bf16*)(ws + WS_SSM_B); unsigned* CT = (unsigned*)(ws + WS_SSM_C); float* LM = (float*)(ws + WS_SSM_L);
      for (int i = gt; i < 32 * 64 * 16; i += NGT) { const int gp = i >> 4, m = i & 15, g = gp >> 6, p = gp & 63;
          const float br = bre[i], bi = bim[i], c0 = cre[i], c1 = -cim[i];
          const float dt = __expf(ldt[g]); const float lr = fminf(lre[gp], -1e-4f), li = lim[gp];
          const float x = lr * dt; const float em1 = x * (1.f + x * (0.5f + x * (0.16666667f + x * (0.041666668f + x * 0.0083333338f))));
          double rev = (double)li * (double)dt * 0.15915494309189535; double revh = 0.5 * rev; rev -= floor(rev); revh -= floor(revh);
          const float co = __builtin_amdgcn_cosf((float)rev), si = __builtin_amdgcn_sinf((float)rev), sh = __builtin_amdgcn_sinf((float)revh);
          const float cm1 = -2.f * sh * sh, mag = 1.f + em1;
          const float lbr = mag * co, lbi = mag * si, nr = em1 * co + cm1, den = lr * lr + li * li;
          const float cr = (nr * lr + lbi * li) / den, ci = (lbi * lr - nr * li) / den;
          if (m == 0) { double revT = (double)li * (double)dt * (128.0 * 0.15915494309189535); revT -= floor(revT);
              const float magT = __expf(x * 128.f), lTr = magT * __builtin_amdgcn_cosf((float)revT), lTi = magT * __builtin_amdgcn_sinf((float)revT);
              *(f32x4*)(LM + gp * 4) = (f32x4){lbr, lbi, lTr, lTi}; }
          const float bbr = cr * br - ci * bi, bbi = cr * bi + ci * br; const unsigned w = pk2(bbr, bbi);
          BT[((size_t)g * 128 + 2 * p) * 16 + m] = (bf16)(w & 0xffffu); BT[((size_t)g * 128 + 2 * p + 1) * 16 + m] = (bf16)(w >> 16);
          CT[i] = pk2(c0, c1); } }
    PBE(102);
    PBS(103);
    { f32x4 va[4], vb[4]; int m = gw;
#define Z0_LOAD(M, V) do { const f32x4* xr_ = (const f32x4*)(a.in[0] + (size_t)(M) * DM) + F.lane; _Pragma("unroll") for (int j = 0; j < 4; ++j) V[j] = xr_[64 * j]; } while (0)
      if (m < NT) Z0_LOAD(m, va);
      for (; m < NT; m += 2 * NGW) {
          if (m + NGW < NT) Z0_LOAD(m + NGW, vb);
          rms_row_to_i8(va, ws + WS_Z + (size_t)m * DM, (float*)(ws + WS_SA) + m, F.lane);
          if (m + NGW < NT) { if (m + 2 * NGW < NT) Z0_LOAD(m + 2 * NGW, va); rms_row_to_i8(vb, ws + WS_Z + (size_t)(m + NGW) * DM, (float*)(ws + WS_SA) + m + NGW, F.lane); } }
#undef Z0_LOAD
    }
    PBE(103);
}

template <bool XF32> struct RowIn { f32x4 hf[XF32 ? 4 : 1]; v2u hb[XF32 ? 1 : 4]; v2u mw[4]; };
template <bool XF32>
__device__ __forceinline__ void rn_load(const void* hprev, const bf16* mix, int lane, RowIn<XF32>& R) {
    const v2u* mp = (const v2u*)mix + lane;
#pragma unroll
    for (int j = 0; j < 4; ++j) R.mw[j] = mp[64 * j];
    if (XF32) { const f32x4* xp = (const f32x4*)hprev + lane;
#pragma unroll
        for (int j = 0; j < 4; ++j) R.hf[XF32 ? j : 0] = xp[64 * j];
    } else { const v2u* xp = (const v2u*)hprev + lane;
#pragma unroll
        for (int j = 0; j < 4; ++j) R.hb[XF32 ? 0 : j] = xp[64 * j]; }
}
template <bool XF32, bool Q8 = false>
__device__ __forceinline__ void rn_compute(const RowIn<XF32>& R, const float* gpost, bf16* hout, float* rstd_out, int lane, f32x4 (&hv)[4], float& rstd_h, unsigned char* z8 = nullptr, float* sa_out = nullptr) {
    const f32x4* gp = (const f32x4*)gpost + lane;
    f32x4 mv[4]; float s = 0.f;
#pragma unroll
    for (int j = 0; j < 4; ++j) { const v2u w = R.mw[j]; mv[j] = (f32x4){bf_lo(w.x), bf_hi(w.x), bf_lo(w.y), bf_hi(w.y)}; s += (mv[j].x * mv[j].x + mv[j].y * mv[j].y) + (mv[j].z * mv[j].z + mv[j].w * mv[j].w); }
    f32x4 hp[4];
#pragma unroll
    for (int j = 0; j < 4; ++j) { if (XF32) hp[j] = R.hf[XF32 ? j : 0]; else { const v2u w = R.hb[XF32 ? 0 : j]; hp[j] = (f32x4){bf_lo(w.x), bf_hi(w.x), bf_lo(w.y), bf_hi(w.y)}; } }
    const float rstd = 1.0f / sqrtf(wave_sum(s) * (1.f / DM) + NORM_EPS);
    float s2 = 0.f;
#pragma unroll
    for (int j = 0; j < 4; ++j) { hv[j] = hp[j] + mv[j] * rstd * gp[64 * j]; s2 += (hv[j].x * hv[j].x + hv[j].y * hv[j].y) + (hv[j].z * hv[j].z + hv[j].w * hv[j].w); }
    rstd_h = 1.0f / sqrtf(wave_sum(s2) * (1.f / DM) + NORM_EPS);
    v2u* ho = (v2u*)hout + lane;
#pragma unroll
    for (int j = 0; j < 4; ++j) { v2u w; w.x = pk2(hv[j].x, hv[j].y); w.y = pk2(hv[j].z, hv[j].w); ho[64 * j] = w; }
    if (lane == 0) *rstd_out = rstd_h;
    if (Q8) { float am = 0.f;
#pragma unroll
        for (int j = 0; j < 4; ++j) { const f32x4 z = __builtin_elementwise_abs(hv[j]); am = fmaxf(am, fmaxf(fmaxf(z.x, z.y), fmaxf(z.z, z.w))); }
        am = fmaxf(wave_max(am) * rstd_h, 1e-30f); const float q = rstd_h * (127.0f / am);
        unsigned* zo = (unsigned*)z8 + lane;
#pragma unroll
        for (int j = 0; j < 4; ++j) zo[64 * j] = pk4_i8(hv[j].x * q, hv[j].y * q, hv[j].z * q, hv[j].w * q);
        if (lane == 0) *sa_out = am * (1.0f / 127.0f); }
}
template <bool XF32, bool Q8 = false>
__device__ __forceinline__ void resnorm_phase(const Args& a, Frame& F, const void* hprev, const float* gpost) {
    unsigned char* ws = a.ws; const int gw = F.vcu * NWAVES + F.wave, NGW = F.G * NWAVES;
    const size_t hb = (size_t)DM * (XF32 ? 4 : 2);
#define RN_LOAD(M, R) rn_load<XF32>((const unsigned char*)hprev + (size_t)(M) * hb, (const bf16*)(ws + WS_MIX) + (size_t)(M) * DM, F.lane, R)
#define RN_COMP(M, R) do { f32x4 hv_[4]; float rh_; rn_compute<XF32, Q8>(R, gpost, (bf16*)(ws + WS_H) + (size_t)(M) * DM, (float*)(ws + WS_RSTDQ) + (M), F.lane, hv_, rh_, ws + WS_Z + (size_t)(M) * DM, (float*)(ws + WS_SA) + (M)); } while (0)
    RowIn<XF32> RA, RB; int m = gw;
    if (m < NT) RN_LOAD(m, RA);
    for (; m < NT; m += 2 * NGW) {
        if (m + NGW < NT) RN_LOAD(m + NGW, RB);
        RN_COMP(m, RA);
        if (m + NGW < NT) { if (m + 2 * NGW < NT) RN_LOAD(m + 2 * NGW, RA); RN_COMP(m + NGW, RB); } }
#undef RN_LOAD
#undef RN_COMP
}

__device__ __forceinline__ float dpp_swap1(float v) { return __builtin_bit_cast(float, __builtin_amdgcn_update_dpp(0, __builtin_bit_cast(int, v), 0xB1, 0xF, 0xF, true)); }
typedef short v4i16_t __attribute__((ext_vector_type(4)));
__device__ __forceinline__ f32x4 mfma16(bf16x8 a, bf16x8 b, f32x4 c) { return __builtin_amdgcn_mfma_f32_16x16x32_bf16(a, b, c, 0, 0, 0); }
constexpr int SSM_CH = 128;
__device__ __forceinline__ void ssm_block(const Args& a, Frame& F, int blk) {
    const int b = blk >> 5, g = blk & 31, lane = F.lane, w = F.wave, c = lane & 15, q = lane >> 4;
    unsigned char* ws = a.ws;
    const bf16* U = (const bf16*)(ws + WS_USSM); bf16* YB = (bf16*)(ws + WS_YB);
    const bf16* BT = (const bf16*)(ws + WS_SSM_B) + (size_t)g * 128 * 16;
    const bf16* CT = (const bf16*)(ws + WS_SSM_C) + (size_t)g * 16 * 128;
    const float* LM = (const float*)(ws + WS_SSM_L) + (size_t)g * 64 * 4;
    LAS float* S = (LAS float*)F.lds;
    LAS float* Gb = (LAS float*)(F.lds + 16384);
    LAS bf16* Hst = (LAS bf16*)(F.lds + 32768 + w * 4096);
    const bf16x8 zero8 = {0, 0, 0, 0, 0, 0, 0, 0};
    bf16x8 bfr[8]; float cr[8], cs[8];
#pragma unroll
    for (int j = 0; j < 8; ++j) { bfr[j] = (q < 2) ? *(const bf16x8*)(BT + (16 * j + c) * 16 + 8 * q) : zero8;
        const int p = 8 * j + (c >> 1); cr[j] = LM[p * 4 + 0]; const float li = LM[p * 4 + 1]; cs[j] = (c & 1) ? li : -li; }
    bf16x8 cfr[4];
#pragma unroll
    for (int s2 = 0; s2 < 4; ++s2) cfr[s2] = *(const bf16x8*)(CT + c * 128 + 32 * s2 + 8 * q);
    const float dval = a.in[10][g * 16 + c];
    const int qa = c >> 2, ra = c & 3;
    const bf16* ua = U + ((size_t)b * SEQ + (size_t)(4 * w + qa) * SSM_CH + ra) * 512 + g * 16 + 8 * (q & 1);
    const f32x4 z4 = {0.f, 0.f, 0.f, 0.f};
    float xp[8];
#pragma unroll
    for (int j = 0; j < 8; ++j) xp[j] = 0.f;
    bf16x8 afq[4];
#pragma unroll
    for (int u = 0; u < 4; ++u) { afq[u] = zero8; if (q < 2) afq[u] = *(const bf16x8*)(ua + (size_t)u * 4 * 512); }
    for (int s4 = 0; s4 < SSM_CH / 16; ++s4) {
#pragma unroll
        for (int u = 0; u < 4; ++u) { const int s = 4 * s4 + u; const bf16x8 af = afq[u];
            if (q < 2 && s + 4 < SSM_CH / 4) afq[u] = *(const bf16x8*)(ua + (size_t)(s + 4) * 4 * 512);
#pragma unroll
            for (int j = 0; j < 8; ++j) { const f32x4 d = mfma16(af, bfr[j], z4);
                float x = xp[j];
#pragma unroll
                for (int r = 0; r < 4; ++r) x = d[r] + cr[j] * x + cs[j] * dpp_swap1(x);
                xp[j] = x; } }
    }
#pragma unroll
    for (int j = 0; j < 8; ++j) S[(4 * w + q) * 128 + 16 * j + c] = xp[j];
    __syncthreads();
    if (w == 0) { const int p = lane; const float lTr = LM[p * 4 + 2], lTi = LM[p * 4 + 3]; float gr = 0.f, gi = 0.f;
        for (int k = 0; k < 32; ++k) { Gb[k * 128 + 2 * p] = gr; Gb[k * 128 + 2 * p + 1] = gi; const float sr = S[k * 128 + 2 * p], si = S[k * 128 + 2 * p + 1];
            const float nr = lTr * gr - lTi * gi + sr, ni = lTr * gi + lTi * gr + si; gr = nr; gi = ni; } }
    __syncthreads();
#pragma unroll
    for (int j = 0; j < 8; ++j) xp[j] = Gb[(4 * w + q) * 128 + 16 * j + c];
    const size_t tok0 = (size_t)b * SEQ + (size_t)(4 * w + q) * SSM_CH;
    const bf16* ud = U + tok0 * 512 + g * 16 + c;
    float uq[4][4];
#pragma unroll
    for (int u = 0; u < 4; ++u) { afq[u] = zero8; if (q < 2) afq[u] = *(const bf16x8*)(ua + (size_t)u * 4 * 512);
#pragma unroll
        for (int r = 0; r < 4; ++r) uq[u][r] = bf_lo((unsigned)ud[(size_t)(4 * u + r) * 512]); }
    for (int s4 = 0; s4 < SSM_CH / 16; ++s4) {
#pragma unroll
      for (int u = 0; u < 4; ++u) { const int s = 4 * s4 + u; const bf16x8 af = afq[u]; float uv[4];
#pragma unroll
        for (int r = 0; r < 4; ++r) uv[r] = uq[u][r];
        if (s + 4 < SSM_CH / 4) { if (q < 2) afq[u] = *(const bf16x8*)(ua + (size_t)(s + 4) * 4 * 512);
#pragma unroll
            for (int r = 0; r < 4; ++r) uq[u][r] = bf_lo((unsigned)ud[(size_t)(4 * (s + 4) + r) * 512]); }
#pragma unroll
        for (int j = 0; j < 8; ++j) { const f32x4 d = mfma16(af, bfr[j], z4);
            float x = xp[j]; float xs[4];
#pragma unroll
            for (int r = 0; r < 4; ++r) { x = d[r] + cr[j] * x + cs[j] * dpp_swap1(x); xs[r] = x; }
            xp[j] = x;
            v2u hw; hw.x = pk2(xs[0], xs[1]); hw.y = pk2(xs[2], xs[3]);
            *(LAS v2u*)(Hst + (16 * j + c) * 16 + 4 * q) = hw; }
        f32x4 y = z4;
#pragma unroll
        for (int s2 = 0; s2 < 4; ++s2) { const LAS unsigned char* hp = (const LAS unsigned char*)Hst + (32 * s2 + 8 * q + ((lane & 15) >> 2)) * 32 + (lane & 3) * 8;
            const v4i16_t lo = __builtin_amdgcn_ds_read_tr16_b64_v4i16((LAS v4i16_t*)hp), hi = __builtin_amdgcn_ds_read_tr16_b64_v4i16((LAS v4i16_t*)(hp + 128));
            const bf16x8 hf = {lo[0], lo[1], lo[2], lo[3], hi[0], hi[1], hi[2], hi[3]}; y = mfma16(hf, cfr[s2], y); }
#pragma unroll
        for (int r = 0; r < 4; ++r) { const size_t o = (tok0 + 4 * s + r) * 512 + g * 16 + c; const float v = y[r] + dval * uv[r];
            YB[o] = (bf16)(pk2(gelu_f(v), 0.f) & 0xffffu); } }
    }
}
constexpr int SGU_VP = 1040;
__device__ __forceinline__ void sgu_block(const Args& a, Frame& F, int item) {
    asm volatile("" : "+s"(item));
    int lane = F.lane; asm volatile("" : "+v"(lane));
    const int b = item >> 5, ck = item & 31, h = F.wave, c = lane & 15, q = lane >> 4;
    unsigned char* ws = a.ws; const size_t T0 = (size_t)b * SEQ + (size_t)ck * 128;
    const bf16* GV = (const bf16*)(ws + WS_GV); const bf16* GU = (const bf16*)(ws + WS_GU); bf16* MC = (bf16*)(ws + WS_MIXCAT0);
    LAS unsigned char* Vs = F.lds;
    LAS float* part = (LAS float*)(F.lds + 139264);
    LAS float* lgb = (LAS float*)(F.lds + 133120);
    { const int s = F.tid & 127, cq = F.tid >> 7; const v4u* src = (const v4u*)(GV + (T0 + s) * 512 + cq * 128);
      v4u xv[16]; float sum = 0.f, sq = 0.f;
#pragma unroll
      for (int i = 0; i < 16; ++i) xv[i] = src[i];
      lgb[F.tid] = a.in[12][F.tid]; lgb[512 + F.tid] = a.in[13][F.tid];
#pragma unroll
      for (int i = 0; i < 16; ++i) { const v4u x = xv[i];
          const float f0 = bf_lo(x.x), f1 = bf_hi(x.x), f2 = bf_lo(x.y), f3 = bf_hi(x.y), f4 = bf_lo(x.z), f5 = bf_hi(x.z), f6 = bf_lo(x.w), f7 = bf_hi(x.w);
          sum += ((f0 + f1) + (f2 + f3)) + ((f4 + f5) + (f6 + f7)); sq += ((f0 * f0 + f1 * f1) + (f2 * f2 + f3 * f3)) + ((f4 * f4 + f5 * f5) + (f6 * f6 + f7 * f7)); }
      part[(cq * 128 + s) * 2] = sum; part[(cq * 128 + s) * 2 + 1] = sq;
#pragma unroll
      for (int i = 0; i < 16; ++i) asm volatile("" : "+v"(xv[i].x), "+v"(xv[i].y), "+v"(xv[i].z), "+v"(xv[i].w));
      __syncthreads();
      float ts = 0.f, tq = 0.f;
#pragma unroll
      for (int k = 0; k < 4; ++k) { ts += part[(k * 128 + s) * 2]; tq += part[(k * 128 + s) * 2 + 1]; }
      const float mean = ts * (1.f / 512.f), var = fmaxf(tq * (1.f / 512.f) - mean * mean, 0.f), rstd = 1.0f / sqrtf(var + NORM_EPS);
      const LAS float* lng = lgb + cq * 128; const LAS float* lnb = lgb + 512 + cq * 128;
      LAS unsigned char* vrow = Vs + s * SGU_VP + cq * 256;
#pragma unroll
      for (int i = 0; i < 16; ++i) { const v4u x = xv[i]; const f32x4 g0 = *(const LAS f32x4*)(lng + 8 * i), g1 = *(const LAS f32x4*)(lng + 8 * i + 4), b0 = *(const LAS f32x4*)(lnb + 8 * i), b1 = *(const LAS f32x4*)(lnb + 8 * i + 4);
          v4u o;
          o.x = pk2((bf_lo(x.x) - mean) * rstd * g0.x + b0.x, (bf_hi(x.x) - mean) * rstd * g0.y + b0.y); o.y = pk2((bf_lo(x.y) - mean) * rstd * g0.z + b0.z, (bf_hi(x.y) - mean) * rstd * g0.w + b0.w);
          o.z = pk2((bf_lo(x.z) - mean) * rstd * g1.x + b1.x, (bf_hi(x.z) - mean) * rstd * g1.y + b1.y); o.w = pk2((bf_lo(x.w) - mean) * rstd * g1.z + b1.z, (bf_hi(x.w) - mean) * rstd * g1.w + b1.w);
          *(LAS v4u*)(vrow + 16 * i) = o; }
    }
    __syncthreads();
    const float* Wh = a.in[14] + (size_t)h * 128 * 128; const float* bs = a.in[15] + h * 128;
    const f32x4 z4 = {0.f, 0.f, 0.f, 0.f};
    const bf16* gup = GU + (T0 + c) * 512 + h * 64 + 4 * q;
    bf16* mcp = MC + (T0 + c) * 1024 + 512 + h * 64 + 4 * q;
    const LAS unsigned char* vfp = Vs + (8 * q + (c >> 2)) * SGU_VP + (h * 64 + (c & 3) * 4) * 2;
    f32x4 wl[2][4][2]; v2u uu[2][4]; float bsv[2];
#define SGU_LOAD(MT, P) do { const int nks_ = (16 * (MT) + 15) / 32 + 1; const float* wp_ = Wh + (size_t)(16 * (MT) + c) * 128 + 8 * q; \
        _Pragma("unroll") for (int ks = 0; ks < 4; ++ks) if (ks < nks_) { wl[P][ks][0] = *(const f32x4*)(wp_ + 32 * ks); wl[P][ks][1] = *(const f32x4*)(wp_ + 32 * ks + 4); } \
        _Pragma("unroll") for (int nt = 0; nt < 4; ++nt) uu[P][nt] = *(const v2u*)(gup + (size_t)(16 * (MT)) * 512 + 16 * nt); bsv[P] = bs[16 * (MT) + c]; } while (0)
#define SGU_STEP(MT, P, NEXT) do { __builtin_amdgcn_sched_barrier(0); NEXT; __builtin_amdgcn_sched_barrier(0); \
        f32x4 acc[4] = {z4, z4, z4, z4}; const int t = 16 * (MT) + c; constexpr int nks = (16 * (MT) + 15) / 32 + 1; \
        _Pragma("unroll") for (int ks = 0; ks < nks; ++ks) { const int s0 = 32 * ks + 8 * q; const f32x4 w0 = wl[P][ks][0], w1 = wl[P][ks][1]; \
            const int lim = t - s0;     \
            v4u ap; ap.x = pk2(lim >= 0 ? w0.x : 0.f, lim >= 1 ? w0.y : 0.f); ap.y = pk2(lim >= 2 ? w0.z : 0.f, lim >= 3 ? w0.w : 0.f); ap.z = pk2(lim >= 4 ? w1.x : 0.f, lim >= 5 ? w1.y : 0.f); ap.w = pk2(lim >= 6 ? w1.z : 0.f, lim >= 7 ? w1.w : 0.f); \
            const bf16x8 af = __builtin_bit_cast(bf16x8, ap); \
            _Pragma("unroll") for (int nt = 0; nt < 4; ++nt) { const LAS unsigned char* vp = vfp + (32 * ks) * SGU_VP + 32 * nt; \
                const v4i16_t lo = __builtin_amdgcn_ds_read_tr16_b64_v4i16((LAS v4i16_t*)vp), hi = __builtin_amdgcn_ds_read_tr16_b64_v4i16((LAS v4i16_t*)(vp + 4 * SGU_VP)); \
                const bf16x8 vf = {lo[0], lo[1], lo[2], lo[3], hi[0], hi[1], hi[2], hi[3]}; acc[nt] = mfma16(vf, af, acc[nt]); } } \
        _Pragma("unroll") for (int nt = 0; nt < 4; ++nt) { const v2u u = uu[P][nt]; const float bv = bsv[P]; \
            v2u o; o.x = pk2(bf_lo(u.x) * (acc[nt][0] + bv), bf_hi(u.x) * (acc[nt][1] + bv)); o.y = pk2(bf_lo(u.y) * (acc[nt][2] + bv), bf_hi(u.y) * (acc[nt][3] + bv)); \
            *(v2u*)(mcp + (size_t)(16 * (MT)) * 1024 + 16 * nt) = o; } } while (0)
    SGU_LOAD(0, 0);
    SGU_STEP(0, 0, SGU_LOAD(1, 1)); SGU_STEP(1, 1, SGU_LOAD(2, 0)); SGU_STEP(2, 0, SGU_LOAD(3, 1)); SGU_STEP(3, 1, SGU_LOAD(4, 0));
    SGU_STEP(4, 0, SGU_LOAD(5, 1)); SGU_STEP(5, 1, SGU_LOAD(6, 0)); SGU_STEP(6, 0, SGU_LOAD(7, 1)); SGU_STEP(7, 1, (void)0);
#undef SGU_STEP
#undef SGU_LOAD
    __syncthreads();
}

__device__ __forceinline__ void conv_prep_phase(const Args& a, Frame& F) {
    unsigned char* ws = a.ws; const bf16* HG = (const bf16*)(ws + WS_HGLU); bf16* MC = (bf16*)(ws + WS_MIXCAT1);
    LAS bf16* Xin = (LAS bf16*)F.lds;
    LAS float* Co = (LAS float*)(F.lds + 63488);
    const int tid = F.tid, lane = F.lane, w = F.wave;
    const float* cw = a.in[21]; const float* cb = a.in[22]; const float* lg = a.in[23]; const float* lb = a.in[24];
    float wk[31];
#pragma unroll
    for (int k = 0; k < 31; ++k) wk[k] = cw[k * 512 + tid];
    const float bias = cb[tid];
    for (int item = (int)blockIdx.x; item < NT / 32; item += F.G) {
        const int t0 = item * 32, tl0 = t0 & (SEQ - 1);
        for (int i = tid; i < 62 * 64; i += NTHR) { const int r = i >> 6, cc = i & 63; const int tl = tl0 - 30 + r; v4u v = {0u, 0u, 0u, 0u};
            if (tl >= 0) v = *(const v4u*)(HG + (size_t)(t0 - 30 + r) * 512 + cc * 8);
            *(LAS v4u*)(Xin + r * 512 + cc * 8) = v; }
        __syncthreads();
        { const int ch = tid;
#pragma unroll
          for (int hf = 0; hf < 2; ++hf) { float xin[46];
#pragma unroll
              for (int i = 0; i < 46; ++i) xin[i] = bf_lo((unsigned)Xin[(16 * hf + i) * 512 + ch]);
#pragma unroll
              for (int tt = 0; tt < 16; ++tt) { float acc = bias;
#pragma unroll
                  for (int k = 0; k < 31; ++k) acc += wk[k] * xin[tt + k];
                  Co[(16 * hf + tt) * 512 + ch] = acc; } } }
        __syncthreads();
#pragma unroll
        for (int i = 0; i < 4; ++i) { const int tt = 4 * w + i; const LAS float* row = Co + tt * 512;
            const f32x4 x0 = *(const LAS f32x4*)(row + 4 * lane), x1 = *(const LAS f32x4*)(row + 256 + 4 * lane);
            const float mean = wave_sum((x0.x + x0.y) + (x0.z + x0.w) + (x1.x + x1.y) + (x1.z + x1.w)) * (1.f / 512.f);
            const f32x4 d0 = x0 - mean, d1 = x1 - mean;
            const float var = wave_sum((d0.x * d0.x + d0.y * d0.y) + (d0.z * d0.z + d0.w * d0.w) + (d1.x * d1.x + d1.y * d1.y) + (d1.z * d1.z + d1.w * d1.w)) * (1.f / 512.f);
            const float rstd = 1.0f / sqrtf(var + NORM_EPS);
            const f32x4 g0 = *(const f32x4*)(lg + 4 * lane), g1 = *(const f32x4*)(lg + 256 + 4 * lane), b0 = *(const f32x4*)(lb + 4 * lane), b1 = *(const f32x4*)(lb + 256 + 4 * lane);
            const f32x4 y0 = d0 * rstd * g0 + b0, y1 = d1 * rstd * g1 + b1;
            v2u o0, o1; o0.x = pk2(silu_f(y0.x), silu_f(y0.y)); o0.y = pk2(silu_f(y0.z), silu_f(y0.w)); o1.x = pk2(silu_f(y1.x), silu_f(y1.y)); o1.y = pk2(silu_f(y1.z), silu_f(y1.w));
            bf16* op = MC + (size_t)(t0 + tt) * 1024; *(v2u*)(op + 4 * lane) = o0; *(v2u*)(op + 256 + 4 * lane) = o1; }
        __syncthreads();
    }
    const bf16* CKV = (const bf16*)(ws + WS_CKV); bf16* KK = (bf16*)(ws + WS_KK);
    const float* cs = (const float*)(ws + WS_ROPE);
    const int gw = F.vcu * NWAVES + w, NGW = F.G * NWAVES;
    for (int tok0 = gw * 4; tok0 < NT; tok0 += NGW * 4) {
        unsigned short r1[4], r2[4]; float co[4], si[4];
        const int i = lane & 15, hh = lane >> 4;
#pragma unroll
        for (int u = 0; u < 4; ++u) { const int tok = tok0 + u; r1[u] = CKV[(size_t)tok * 256 + 128 + i]; r2[u] = CKV[(size_t)tok * 256 + 144 + i];
            co[u] = cs[(size_t)(tok & (SEQ - 1)) * 32 + i]; si[u] = cs[(size_t)(tok & (SEQ - 1)) * 32 + 16 + i]; }
#pragma unroll
        for (int u = 0; u < 4; ++u) { const int tok = tok0 + u;
            const float x1 = bf_lo((unsigned)r1[u]), x2 = bf_lo((unsigned)r2[u]);
            const unsigned pw = pk2(x1 * co[u] - x2 * si[u], x2 * co[u] + x1 * si[u]);
            bf16* kp = KK + (size_t)tok * 768 + 64 + i;
            kp[hh * 96] = (bf16)(pw & 0xffffu); kp[hh * 96 + 16] = (bf16)(pw >> 16); kp[(hh + 4) * 96] = (bf16)(pw & 0xffffu); kp[(hh + 4) * 96 + 16] = (bf16)(pw >> 16); }
    }
}

#ifndef ATT_PROBE
#define ATT_PROBE 0
#endif
typedef float f32x16 __attribute__((ext_vector_type(16)));
__device__ __forceinline__ f32x16 mfma32(bf16x8 a, bf16x8 b, f32x16 c) { return __builtin_amdgcn_mfma_f32_32x32x16_bf16(a, b, c, 0, 0, 0); }
__device__ __forceinline__ v4i16_t tr_read(const LAS unsigned char* p) { return __builtin_amdgcn_ds_read_tr16_b64_v4i16((LAS v4i16_t*)p); }
constexpr int AT_KP = 208, AT_VP = 144, AT_KB = 64 * AT_KP, AT_VB = 64 * AT_VP;
__device__ __forceinline__ void attn_tile_A(const LAS unsigned char* kb, const bf16x8 (&qr)[6], f32x16& p0, f32x16& p1, int kt, int q0, int r32, int hi) {
#pragma unroll
    for (int r = 0; r < 16; ++r) { p0[r] = 0.f; p1[r] = 0.f; }
    bf16x8 kf[12];
#pragma unroll
    for (int ds = 0; ds < 3; ++ds) { kf[2 * ds] = *(const LAS bf16x8*)(kb + r32 * AT_KP + ds * 32 + hi * 16); kf[2 * ds + 1] = *(const LAS bf16x8*)(kb + (32 + r32) * AT_KP + ds * 32 + hi * 16); }
    __builtin_amdgcn_sched_barrier(0);
#pragma unroll
    for (int ds = 3; ds < 6; ++ds) { kf[2 * ds] = *(const LAS bf16x8*)(kb + r32 * AT_KP + ds * 32 + hi * 16); kf[2 * ds + 1] = *(const LAS bf16x8*)(kb + (32 + r32) * AT_KP + ds * 32 + hi * 16); }
#pragma unroll
    for (int ds = 0; ds < 3; ++ds) { p0 = mfma32(kf[2 * ds], qr[ds], p0); p1 = mfma32(kf[2 * ds + 1], qr[ds], p1); }
    __builtin_amdgcn_sched_barrier(0);
#pragma unroll
    for (int ds = 3; ds < 6; ++ds) { p0 = mfma32(kf[2 * ds], qr[ds], p0); p1 = mfma32(kf[2 * ds + 1], qr[ds], p1); }
    if (kt * 64 + 63 > q0) { const int qg = q0 + r32;
#pragma unroll
        for (int r = 0; r < 16; ++r) { const int key = kt * 64 + (r & 3) + 8 * (r >> 2) + 4 * hi; if (key > qg) p0[r] = -INFINITY; if (key + 32 > qg) p1[r] = -INFINITY; } }
}
__device__ __forceinline__ void attn_tile_B(const LAS unsigned char* vb, f32x16& p0, f32x16& p1, f32x16& o0, f32x16& o1, float& m, float& l, int kt) {
    v4i16_t vlo[8], vhi[8];
#pragma unroll
    for (int s = 0; s < 4; ++s)
#pragma unroll
        for (int db = 0; db < 2; ++db) { vlo[2 * s + db] = tr_read(vb + (16 * s) * AT_VP + db * 64); vhi[2 * s + db] = tr_read(vb + (16 * s + 8) * AT_VP + db * 64); }
    __builtin_amdgcn_sched_barrier(0);
    if (__any(m != 0.f)) {
#pragma unroll
        for (int r = 0; r < 16; ++r) { p0[r] -= m; p1[r] -= m; } }
    float ma = fmaxf(fmaxf(p0[0], p0[1]), p1[0]), mb = fmaxf(fmaxf(p0[2], p0[3]), p1[1]);
    ma = fmaxf(fmaxf(ma, p1[2]), p1[3]);
#pragma unroll
    for (int r = 4; r < 16; r += 4) { ma = fmaxf(fmaxf(ma, p0[r]), p0[r + 1]); mb = fmaxf(fmaxf(mb, p0[r + 2]), p0[r + 3]); ma = fmaxf(fmaxf(ma, p1[r]), p1[r + 1]); mb = fmaxf(fmaxf(mb, p1[r + 2]), p1[r + 3]); }
    float mt = fmaxf(ma, mb); { const auto rr = __builtin_amdgcn_permlane32_swap(__float_as_uint(mt), __float_as_uint(mt), false, false); mt = fmaxf(__uint_as_float(rr[0]), __uint_as_float(rr[1])); }
    if (__any(mt > 8.0f || (kt == 0 && mt < -24.0f))) {
        const float dl = mt > 8.0f ? mt : ((kt == 0 && mt < -24.0f) ? mt : 0.f); m += dl; const float alpha = __builtin_amdgcn_exp2f(-dl); l *= alpha;
#pragma unroll
        for (int r = 0; r < 16; ++r) { p0[r] -= dl; p1[r] -= dl; o0[r] *= alpha; o1[r] *= alpha; } }
    float ps = 0.f;
#pragma unroll
    for (int r = 0; r < 16; ++r) { p0[r] = __builtin_amdgcn_exp2f(p0[r]); p1[r] = __builtin_amdgcn_exp2f(p1[r]); ps += p0[r] + p1[r]; }
    l += ps;
#if ATT_PROBE == 2
    { float qs = 0.f;
#pragma unroll
      for (int r = 0; r < 16; ++r) { qs += __builtin_amdgcn_exp2f(p0[r] - 1.0f) + __builtin_amdgcn_exp2f(p1[r] - 1.0f); }
      l += 0.f * qs; }
#endif
    v4u w0, w1, w2, w3;
    w0.x = pk2(p0[0], p0[1]); w0.y = pk2(p0[2], p0[3]); w0.z = pk2(p0[4], p0[5]); w0.w = pk2(p0[6], p0[7]);
    w1.x = pk2(p0[8], p0[9]); w1.y = pk2(p0[10], p0[11]); w1.z = pk2(p0[12], p0[13]); w1.w = pk2(p0[14], p0[15]);
    w2.x = pk2(p1[0], p1[1]); w2.y = pk2(p1[2], p1[3]); w2.z = pk2(p1[4], p1[5]); w2.w = pk2(p1[6], p1[7]);
    w3.x = pk2(p1[8], p1[9]); w3.y = pk2(p1[10], p1[11]); w3.z = pk2(p1[12], p1[13]); w3.w = pk2(p1[14], p1[15]);
    const bf16x8 pa0 = __builtin_bit_cast(bf16x8, w0), pa1 = __builtin_bit_cast(bf16x8, w1), pa2 = __builtin_bit_cast(bf16x8, w2), pa3 = __builtin_bit_cast(bf16x8, w3);
#define AT_VF(s, db) ((bf16x8){vlo[2 * (s) + (db)][0], vlo[2 * (s) + (db)][1], vlo[2 * (s) + (db)][2], vlo[2 * (s) + (db)][3], vhi[2 * (s) + (db)][0], vhi[2 * (s) + (db)][1], vhi[2 * (s) + (db)][2], vhi[2 * (s) + (db)][3]})
    o0 = mfma32(AT_VF(0, 0), pa0, o0); o1 = mfma32(AT_VF(0, 1), pa0, o1);
    o0 = mfma32(AT_VF(1, 0), pa1, o0); o1 = mfma32(AT_VF(1, 1), pa1, o1);
    o0 = mfma32(AT_VF(2, 0), pa2, o0); o1 = mfma32(AT_VF(2, 1), pa2, o1);
    o0 = mfma32(AT_VF(3, 0), pa3, o0); o1 = mfma32(AT_VF(3, 1), pa3, o1);
#if ATT_PROBE == 3
    { f32x16 e0, e1;
#pragma unroll
      for (int r = 0; r < 16; ++r) { e0[r] = 0.f; e1[r] = 0.f; }
      e0 = mfma32(AT_VF(0, 0), pa0, e0); e1 = mfma32(AT_VF(0, 1), pa0, e1); e0 = mfma32(AT_VF(1, 0), pa1, e0); e1 = mfma32(AT_VF(1, 1), pa1, e1);
      e0 = mfma32(AT_VF(2, 0), pa2, e0); e1 = mfma32(AT_VF(2, 1), pa2, e1); e0 = mfma32(AT_VF(3, 0), pa3, e0); e1 = mfma32(AT_VF(3, 1), pa3, e1);
#pragma unroll
      for (int r = 0; r < 16; ++r) { o0[r] += 0.f * e0[r]; o1[r] += 0.f * e1[r]; } }
#endif
#undef AT_VF
}
constexpr int AT_STG = 2 * AT_KB + 2 * AT_VB;
__device__ __forceinline__ void attn_unit(const Args& a, Frame& F, int bh, int qblk) {
    unsigned char* ws = a.ws;
    const int b = bh >> 3, h = bh & 7, lane = F.lane, w = F.wave, r32 = lane & 31, hi = lane >> 5, tid = F.tid;
    const bf16* Q = (const bf16*)(ws + WS_Q); const bf16* KK = (const bf16*)(ws + WS_KK); const bf16* VV = (const bf16*)(ws + WS_VV); bf16* O = (bf16*)(ws + WS_MIXCAT1);
    LAS unsigned char* Sb = F.lds; LAS bf16* Ost = (LAS bf16*)(F.lds + 2 * AT_STG + w * 4096);
    const size_t tokb = (size_t)b * SEQ; const int q0 = qblk * 256 + 32 * w;
    bf16x8 qr[6];
    { const bf16* qp = Q + (tokb + q0 + r32) * 768 + h * 96 + 8 * hi;
#pragma unroll
      for (int ds = 0; ds < 6; ++ds) qr[ds] = *(const bf16x8*)(qp + 16 * ds); }
    f32x16 o0, o1, p0, p1, p2, p3;
#pragma unroll
    for (int r = 0; r < 16; ++r) { o0[r] = 0.f; o1[r] = 0.f; }
    float m = 0.f, l = 0.f;
    const int NST = 2 * qblk + 2, ktmax = (q0 + 31) >> 6;
    const bf16* kg[3]; int kl[3]; const bf16* vg[2]; int vl[2];
#pragma unroll
    for (int i = 0; i < 3; ++i) { const int c = tid + 512 * i, tl = c / 768, cc = c - tl * 768, row = cc / 12, col = cc - row * 12; kg[i] = KK + (tokb + tl * 64 + row) * 768 + h * 96 + col * 8; kl[i] = tl * AT_KB + row * AT_KP + col * 16; }
#pragma unroll
    for (int i = 0; i < 2; ++i) { const int v = tid + 512 * i, tl = v >> 9, row = (v & 511) >> 3, col = v & 7; vg[i] = VV + (tokb + tl * 64 + row) * 512 + h * 64 + col * 8; vl[i] = 2 * AT_KB + tl * AT_VB + row * AT_VP + col * 16; }
    v4u rk[3], rv[2];
#define AT_LOAD(ST) do { const int st_ = (ST) < NST ? (ST) : NST - 1; const size_t adv_ = (size_t)st_ * 128; _Pragma("unroll") for (int i = 0; i < 3; ++i) rk[i] = *(const v4u*)(kg[i] + adv_ * 768); _Pragma("unroll") for (int i = 0; i < 2; ++i) rv[i] = *(const v4u*)(vg[i] + adv_ * 512); } while (0)
#define AT_STORE(BUF) do { LAS unsigned char* sb_ = Sb + (BUF) * AT_STG; _Pragma("unroll") for (int i = 0; i < 3; ++i) *(LAS v4u*)(sb_ + kl[i]) = rk[i]; _Pragma("unroll") for (int i = 0; i < 2; ++i) *(LAS v4u*)(sb_ + vl[i]) = rv[i]; } while (0)
#define AT_BAR() do { asm volatile("s_waitcnt lgkmcnt(0)" ::: "memory"); __builtin_amdgcn_s_barrier(); asm volatile("" ::: "memory"); } while (0)
    AT_LOAD(0); AT_STORE(0); AT_BAR(); AT_LOAD(1);
    const int vlane = (4 * hi + ((lane & 15) >> 2)) * AT_VP + ((lane >> 4) & 1) * 32 + (lane & 3) * 8;
    for (int st = 0; st < NST; ++st) {
        const LAS unsigned char* sb = Sb + (st & 1) * AT_STG;
        if (2 * st + 1 <= ktmax) {
            attn_tile_A(sb, qr, p0, p1, 2 * st, q0, r32, hi);
            attn_tile_A(sb + AT_KB, qr, p2, p3, 2 * st + 1, q0, r32, hi);
            attn_tile_B(sb + 2 * AT_KB + vlane, p0, p1, o0, o1, m, l, 2 * st);
            attn_tile_B(sb + 2 * AT_KB + AT_VB + vlane, p2, p3, o0, o1, m, l, 2 * st + 1);
        } else if (2 * st <= ktmax) { attn_tile_A(sb, qr, p0, p1, 2 * st, q0, r32, hi); attn_tile_B(sb + 2 * AT_KB + vlane, p0, p1, o0, o1, m, l, 2 * st); }
        if (st + 1 < NST) AT_STORE((st + 1) & 1);
        AT_BAR();
        AT_LOAD(st + 2);
    }
#undef AT_LOAD
#undef AT_STORE
#undef AT_BAR
    l += __shfl_xor(l, 32);
    const float inv = 1.0f / l;
#pragma unroll
    for (int r = 0; r < 16; ++r) { const int d = (r & 3) + 8 * (r >> 2) + 4 * hi; const unsigned pw = pk2(o0[r] * inv, o1[r] * inv);
        Ost[r32 * 64 + d] = (bf16)(pw & 0xffffu); Ost[r32 * 64 + 32 + d] = (bf16)(pw >> 16); }
#pragma unroll
    for (int i = 0; i < 4; ++i) { const int id = i * 64 + lane, row = id >> 3, cc = id & 7; const v4u v = *(const LAS v4u*)(Ost + row * 64 + cc * 8);
        *(v4u*)(O + (tokb + q0 + row) * 1024 + 512 + h * 64 + cc * 8) = v; }
    __syncthreads();
}
__device__ __forceinline__ void attn_phase(const Args& a, Frame& F) {
    for (int u = (int)blockIdx.x; u < 512; u += F.G) { const int v = u & 255, bh = v >> 3, s = v & 7; attn_unit(a, F, bh, u < 256 ? s : 15 - s); }
}

__device__ __forceinline__ void resnorm_router_phase(const Args& a, Frame& F, const float* gpost, const float* gpre) {
    unsigned char* ws = a.ws; const int lane = F.lane, w = F.wave, tid = F.tid;
    LAS int* cnt = (LAS int*)F.lds;
    const float* wr = a.in[30]; int* tok_e = (int*)(ws + WS_TOKE); float* tok_w = (float*)(ws + WS_TOKW); int* bcnt = (int*)(ws + WS_BCNT);
    for (int grp = (int)blockIdx.x; grp < NT / 64; grp += F.G) {
        if (tid < 8) cnt[tid] = 0;
        __syncthreads();
        f32x4 wa[4][4], wb[4][4];
#pragma unroll
        for (int j = 0; j < 4; ++j) { const int k0 = 256 * j + 4 * lane; const f32x4 g = *(const f32x4*)(gpre + k0);
#pragma unroll
            for (int c = 0; c < 4; ++c) { wa[j][c] = *(const f32x4*)(wr + (size_t)(k0 + c) * 8) * g[c]; wb[j][c] = *(const f32x4*)(wr + (size_t)(k0 + c) * 8 + 4) * g[c]; } }
        RowIn<false> RI[2];
        rn_load<false>((const bf16*)(ws + WS_H) + (size_t)(grp * 64 + w * 8) * DM, (const bf16*)(ws + WS_MIX) + (size_t)(grp * 64 + w * 8) * DM, lane, RI[0]);
#pragma unroll
        for (int i = 0; i < 8; ++i) { const int tok = grp * 64 + w * 8 + i; f32x4 hv[4]; float rh;
            if (i < 7) rn_load<false>((const bf16*)(ws + WS_H) + (size_t)(tok + 1) * DM, (const bf16*)(ws + WS_MIX) + (size_t)(tok + 1) * DM, lane, RI[(i + 1) & 1]);
            rn_compute<false>(RI[i & 1], gpost, (bf16*)(ws + WS_H) + (size_t)tok * DM, (float*)(ws + WS_RSTDQ) + tok, lane, hv, rh);
            float l0 = 0.f, l1 = 0.f, l2 = 0.f, l3 = 0.f, l4 = 0.f, l5 = 0.f, l6 = 0.f, l7 = 0.f;
#pragma unroll
            for (int j = 0; j < 4; ++j) { const f32x4 z = hv[j] * rh;
#pragma unroll
                for (int c = 0; c < 4; ++c) { const float zc = z[c]; const f32x4 ua = wa[j][c], ub = wb[j][c];
                    l0 += zc * ua.x; l1 += zc * ua.y; l2 += zc * ua.z; l3 += zc * ua.w; l4 += zc * ub.x; l5 += zc * ub.y; l6 += zc * ub.z; l7 += zc * ub.w; } }
            l0 = wave_sum(l0); l1 = wave_sum(l1); l2 = wave_sum(l2); l3 = wave_sum(l3); l4 = wave_sum(l4); l5 = wave_sum(l5); l6 = wave_sum(l6); l7 = wave_sum(l7);
            int i0 = 0; float v0 = l0;
            if (l1 > v0) { v0 = l1; i0 = 1; } if (l2 > v0) { v0 = l2; i0 = 2; } if (l3 > v0) { v0 = l3; i0 = 3; } if (l4 > v0) { v0 = l4; i0 = 4; } if (l5 > v0) { v0 = l5; i0 = 5; } if (l6 > v0) { v0 = l6; i0 = 6; } if (l7 > v0) { v0 = l7; i0 = 7; }
            int i1 = -1; float v1 = -INFINITY;
            if (i0 != 0 && l0 > v1) { v1 = l0; i1 = 0; } if (i0 != 1 && l1 > v1) { v1 = l1; i1 = 1; } if (i0 != 2 && l2 > v1) { v1 = l2; i1 = 2; } if (i0 != 3 && l3 > v1) { v1 = l3; i1 = 3; }
            if (i0 != 4 && l4 > v1) { v1 = l4; i1 = 4; } if (i0 != 5 && l5 > v1) { v1 = l5; i1 = 5; } if (i0 != 6 && l6 > v1) { v1 = l6; i1 = 6; } if (i0 != 7 && l7 > v1) { v1 = l7; i1 = 7; }
            const float w0 = 1.0f / (1.0f + __expf(v1 - v0));
            if (lane == 0) { tok_e[tok * 2] = i0; tok_e[tok * 2 + 1] = i1; tok_w[tok * 2] = w0; tok_w[tok * 2 + 1] = 1.0f - w0; __hip_atomic_fetch_add(&cnt[i0], 1, __ATOMIC_RELAXED, __HIP_MEMORY_SCOPE_WORKGROUP); __hip_atomic_fetch_add(&cnt[i1], 1, __ATOMIC_RELAXED, __HIP_MEMORY_SCOPE_WORKGROUP); } }
        __syncthreads();
        if (tid < 8) bcnt[grp * 8 + tid] = cnt[tid];
        __syncthreads();
    }
}
__device__ __forceinline__ void moe_gather_phase(const Args& a, Frame& F) {
    unsigned char* ws = a.ws; const int lane = F.lane, w = F.wave, tid = F.tid;
    LAS int* tot = (LAS int*)F.lds; LAS int* pre = tot + 8; LAS int* base = tot + 16; LAS int* rowtab = tot + 32;
    const int* bcnt = (const int*)(ws + WS_BCNT); const int* tok_e = (const int*)(ws + WS_TOKE); int* tok_row = (int*)(ws + WS_TOKR); int* meta = (int*)(ws + WS_META);
    const bf16* Z = (const bf16*)(ws + WS_H); const float* rsh = (const float*)(ws + WS_RSTDQ); unsigned char* AG = ws + WS_AG8;
    for (int grp = (int)blockIdx.x; grp < NT / 64; grp += F.G) {
        if (w < 4) { const int4 c0 = *(const int4*)(bcnt + tid * 8), c1 = *(const int4*)(bcnt + tid * 8 + 4); const int pr = tid < grp ? 1 : 0;
            int v[16] = {c0.x, c0.y, c0.z, c0.w, c1.x, c1.y, c1.z, c1.w, pr * c0.x, pr * c0.y, pr * c0.z, pr * c0.w, pr * c1.x, pr * c1.y, pr * c1.z, pr * c1.w};
#pragma unroll
            for (int k = 0; k < 16; ++k) { int t = v[k];
                t += __builtin_amdgcn_update_dpp(0, t, 0xB1, 0xF, 0xF, false); t += __builtin_amdgcn_update_dpp(0, t, 0x4E, 0xF, 0xF, false); t += __builtin_amdgcn_update_dpp(0, t, 0x141, 0xF, 0xF, false);
                t += __builtin_amdgcn_update_dpp(0, t, 0x140, 0xF, 0xF, false); t += __builtin_amdgcn_update_dpp(0, t, 0x142, 0xA, 0xF, false); t += __builtin_amdgcn_update_dpp(0, t, 0x143, 0xC, 0xF, false);
                if (lane == 63) rowtab[w * 16 + k] = t; } }
        __syncthreads();
        if (tid < 16) tot[tid] = rowtab[tid] + rowtab[16 + tid] + rowtab[32 + tid] + rowtab[48 + tid];
        __syncthreads();
        if (tid == 0) { int tp = 0; for (int e = 0; e < 8; ++e) { base[e] = tp * 256; if (grp == 0) meta[e] = tp; tp += (tot[e] + 255) >> 8; } if (grp == 0) meta[8] = tp; }
        __syncthreads();
        if (w == 0) { const int tok = grp * 64 + lane; const int e0 = tok_e[tok * 2], e1 = tok_e[tok * 2 + 1]; const unsigned long long lt = (1ull << lane) - 1ull;
            int r0 = 0, r1 = 0;
#pragma unroll
            for (int ex = 0; ex < 8; ++ex) { const unsigned long long m0 = __ballot(e0 == ex), m1 = __ballot(e1 == ex); const int b0 = base[ex] + pre[ex], n0 = __popcll(m0);
                if (e0 == ex) r0 = b0 + __popcll(m0 & lt); if (e1 == ex) r1 = b0 + n0 + __popcll(m1 & lt); }
            tok_row[tok * 2] = r0; tok_row[tok * 2 + 1] = r1; rowtab[lane * 2] = r0; rowtab[lane * 2 + 1] = r1; }
        __syncthreads();
        { v4u xa[8], xb[8]; int rows[8]; float rs[8];
#pragma unroll
          for (int hb = 0; hb < 2; ++hb) {
#pragma unroll
            for (int i = 0; i < 8; ++i) { const int pidx = w * 16 + hb * 8 + i; const int tok = grp * 64 + (pidx >> 1); rows[i] = rowtab[pidx]; rs[i] = rsh[tok];
                const v4u* src = (const v4u*)(Z + (size_t)tok * DM) + 2 * lane; xa[i] = src[0]; xb[i] = src[1]; }
#pragma unroll
            for (int i = 0; i < 8; ++i) { const v4u x0 = xa[i], x1 = xb[i]; const float r = rs[i];
                v4u o; o.x = pg8::pk4_fp8(bf_lo(x0.x) * r, bf_hi(x0.x) * r, bf_lo(x0.y) * r, bf_hi(x0.y) * r); o.y = pg8::pk4_fp8(bf_lo(x0.z) * r, bf_hi(x0.z) * r, bf_lo(x0.w) * r, bf_hi(x0.w) * r);
                o.z = pg8::pk4_fp8(bf_lo(x1.x) * r, bf_hi(x1.x) * r, bf_lo(x1.y) * r, bf_hi(x1.y) * r); o.w = pg8::pk4_fp8(bf_lo(x1.z) * r, bf_hi(x1.z) * r, bf_lo(x1.w) * r, bf_hi(x1.w) * r);
                *((v4u*)(AG + (size_t)rows[i] * DM) + lane) = o; } } }
        __syncthreads();
    }
}
__device__ __forceinline__ void moe_combine_phase(const Args& a, Frame& F, const float* gpost, int late) {
    unsigned char* ws = a.ws; const int lane = F.lane; const int gw = F.vcu * NWAVES + F.wave, NGW = F.G * NWAVES;
    const int* tok_row = (const int*)(ws + WS_TOKR); const float* tok_w = (const float*)(ws + WS_TOKW); const bf16* HO = (const bf16*)(ws + WS_HOUT);
    struct CIn { v2u x[4], y[4], hw[4]; float w0, w1; };
#define CB_LOAD(T, C) do { const int r0_ = tok_row[(T) * 2], r1_ = tok_row[(T) * 2 + 1]; C.w0 = tok_w[(T) * 2]; C.w1 = tok_w[(T) * 2 + 1]; \
        const v2u* p0_ = (const v2u*)(HO + (size_t)r0_ * DM) + lane; const v2u* p1_ = (const v2u*)(HO + (size_t)r1_ * DM) + lane; const v2u* hp_ = (const v2u*)((const bf16*)(ws + WS_H) + (size_t)(T) * DM) + lane; \
        _Pragma("unroll") for (int j = 0; j < 4; ++j) { C.x[j] = p0_[64 * j]; C.y[j] = p1_[64 * j]; C.hw[j] = hp_[64 * j]; } \
        if (r0_ >= late) CB_LATE(r0_, C.x); if (r1_ >= late) CB_LATE(r1_, C.y); } while (0)
#define CB_LATE(R, X) do { const v2u* pp_ = (const v2u*)((const bf16*)(ws + WS_PART) + (size_t)((R) - late) * DM) + lane; f32x4 s_[4]; \
        _Pragma("unroll") for (int j = 0; j < 4; ++j) s_[j] = (f32x4){0.f, 0.f, 0.f, 0.f}; \
        _Pragma("unroll") for (int q = 0; q < pg8::SPLIT_S; ++q) _Pragma("unroll") for (int j = 0; j < 4; ++j) { const v2u t_ = pp_[(size_t)q * (pg8::SPLIT_RT * 256 * DM / 4) + 64 * j]; s_[j] += (f32x4){bf_lo(t_.x), bf_hi(t_.x), bf_lo(t_.y), bf_hi(t_.y)}; } \
        _Pragma("unroll") for (int j = 0; j < 4; ++j) { X[j].x = pk2(s_[j].x, s_[j].y); X[j].y = pk2(s_[j].z, s_[j].w); } } while (0)
#define CB_COMP(T, C) do { f32x4 f[4]; float s = 0.f; const float w0 = C.w0, w1 = C.w1; \
        _Pragma("unroll") for (int j = 0; j < 4; ++j) { const v2u x = C.x[j], y = C.y[j]; \
            f[j] = (f32x4){w0 * bf_lo(x.x) + w1 * bf_lo(y.x), w0 * bf_hi(x.x) + w1 * bf_hi(y.x), w0 * bf_lo(x.y) + w1 * bf_lo(y.y), w0 * bf_hi(x.y) + w1 * bf_hi(y.y)}; \
            s += (f[j].x * f[j].x + f[j].y * f[j].y) + (f[j].z * f[j].z + f[j].w * f[j].w); } \
        const float rstd = 1.0f / sqrtf(wave_sum(s) * (1.f / DM) + NORM_EPS); const f32x4* gp = (const f32x4*)gpost + lane; f32x4* op = (f32x4*)(a.out + (size_t)(T) * DM) + lane; \
        _Pragma("unroll") for (int j = 0; j < 4; ++j) { const v2u hw = C.hw[j]; op[64 * j] = (f32x4){bf_lo(hw.x), bf_hi(hw.x), bf_lo(hw.y), bf_hi(hw.y)} + f[j] * rstd * gp[64 * j]; } } while (0)
    CIn CA, CB; int tok = gw;
    if (tok < NT) CB_LOAD(tok, CA);
    for (; tok < NT; tok += 2 * NGW) {
        if (tok + NGW < NT) CB_LOAD(tok + NGW, CB);
        CB_COMP(tok, CA);
        if (tok + NGW < NT) { if (tok + 2 * NGW < NT) CB_LOAD(tok + 2 * NGW, CA); CB_COMP(tok + NGW, CB); } }
#undef CB_LOAD
#undef CB_LATE
#undef CB_COMP
}

constexpr int NPHASE = 19;
#ifndef DBG_STOP
#define DBG_STOP 18
#endif
#ifndef PHMASK
#define PHMASK 0xFFFFFFFFu
#endif
#ifndef REP_MASK
#define REP_MASK 0
#endif
#ifndef P2_DOUBLE
#define P2_DOUBLE 0
#endif
#ifndef ONE_LAUNCH
#define ONE_LAUNCH 1
#endif
__device__ __forceinline__ pg8::TileOrder moe_order(const unsigned char* ws, int nN, int G, int bx, int tcap = 1 << 20) {
    const int* meta = (const int*)(ws + WS_META); const int nM = meta[8] < tcap ? meta[8] : tcap;
    pg8::TileOrder S; S.init(nM, nN, G, bx, 0); S.grouped = true;
    S.tp1 = meta[1]; S.tp2 = meta[2]; S.tp3 = meta[3]; S.tp4 = meta[4]; S.tp5 = meta[5]; S.tp6 = meta[6]; S.tp7 = meta[7];
    return S;
}
__global__ void __launch_bounds__(NTHR, 2) fwd(Args a) {
    extern __shared__ __attribute__((aligned(16))) unsigned char lds[];
    Frame F;
    F.lds = (LAS unsigned char*)lds; F.MISC = (volatile LAS unsigned*)(F.lds + MISC_OFF);
    F.tid = threadIdx.x; F.lane = F.tid & 63; F.wave = __builtin_amdgcn_readfirstlane(F.tid >> 6);
    F.G = gridDim.x; { const int bx = blockIdx.x; F.vcu = (F.G % 8 == 0) ? (bx % 8) * (F.G / 8) + bx / 8 : bx; }
    unsigned char* ws = a.ws; F.ctl = (unsigned*)(ws + WS_CTL);
    for (int u = F.tid; u < 128; u += NTHR) F.MISC[u] = 0u;
    __syncthreads();
    XcdBarrier bar = xcd_barrier_post((unsigned*)(F.ctl + CW_BAR), F.MISC + 8);
    const int lo = a.ph_lo, hi = a.ph_hi;
#define IN(k) (lo <= (k) && (k) < hi)
    unsigned long long pt0_ = 0, pt1_ = 0;
#define PB_A(k) do { if (PROBE_SEL == (k)) pt0_ = wall_clock64(); } while (0)
#define PB_B(k) do { if (PROBE_SEL == (k)) { __syncthreads(); pt1_ = wall_clock64(); if (PROBE_KIND == 0 && bx == PROBE_BLK && F.tid == 0) F.ctl[CW_PROBE] = (unsigned)(pt1_ - pt0_); } } while (0)
#define PB_C(k) do { if (PROBE_SEL == (k) && PROBE_KIND >= 1) { if (bx == PROBE_BLK && F.tid == 0) F.ctl[CW_PROBE] = (unsigned)(wall_clock64() - (PROBE_KIND == 1 ? pt1_ : pt0_)); } } while (0)
#define SEAM(k) do { PB_B(k); if (IN(k) && IN((k) + 1)) xcd_barrier(bar); PB_C(k); PB_A((k) + 1); } while (0)
    const float* x = a.in[0]; const float* norm_g = a.in[1];
    const int bx = (int)blockIdx.x;
    PB_A(0);
    if (((PHMASK >> 0) & 1) && IN(0)) for (int rep_ = 0; rep_ < ((((unsigned)REP_MASK >> 0) & 1u) ? 2 : 1); ++rep_) { if (rep_) xcd_barrier(bar); p0_prologue(a, F); } SEAM(0);
    if (((PHMASK >> 1) & 1) && IN(1)) for (int rep_ = 0; rep_ < ((((unsigned)REP_MASK >> 1) & 1u) ? 2 : 1); ++rep_) { if (rep_) xcd_barrier(bar);
        pg8::Gemm g{(const bf16*)(ws + WS_Z), (const bf16*)(ws + WS_WIN0), NT, 1536, 1024}; pg8::StaticOrder S; S.init(NT, 1536, F.G, bx);
        pg8::EpiIn0 E{(bf16*)(ws + WS_USSM), (size_t)(WS_GU - WS_USSM) / 2, (const float*)(ws + WS_SA), (const float*)(ws + WS_SB0)};
        pg8::gemm_phase<pg8::EpiIn0, pg8::StaticOrder, true, true, 2>(F.lds, g, S, E);
        moe_convert_slot(a, F, 0, MQ_A, MQ_LO_A);
    } SEAM(1);
    if (((PHMASK >> 2) & 1) && IN(2)) for (int rep_ = 0; rep_ < ((((unsigned)REP_MASK >> 2) & 1u) ? 2 : 1); ++rep_) { if (rep_) xcd_barrier(bar);
        if (F.G >= 256) { if (bx < 128) { ssm_block(a, F, bx); if (P2_DOUBLE == 1) { __syncthreads(); ssm_block(a, F, bx); } __syncthreads(); } else if (bx < 256) { sgu_block(a, F, bx - 128); if (P2_DOUBLE == 2) { __syncthreads(); sgu_block(a, F, bx - 128); } } moe_convert_slot(a, F, MQ_A, MQ_B, MQ_LO_B); }
        else { for (int it = bx; it < 128; it += F.G) { ssm_block(a, F, it); __syncthreads(); } for (int it = bx; it < 128; it += F.G) { sgu_block(a, F, it); __syncthreads(); } }
    } SEAM(2);
    if (((PHMASK >> 3) & 1) && IN(3)) for (int rep_ = 0; rep_ < ((((unsigned)REP_MASK >> 3) & 1u) ? 2 : 1); ++rep_) { if (rep_) xcd_barrier(bar);
        pg8::Gemm g{(const bf16*)(ws + WS_YB), (const bf16*)(ws + WS_WGLU), NT, 512, 512}; pg8::StaticOrder S; S.init(NT, 512, F.G, bx);
        pg8::EpiGlu E{(const bf16*)(ws + WS_YB), (bf16*)(ws + WS_MIXCAT0)};
        pg8::gemm_phase<pg8::EpiGlu, pg8::StaticOrder, true, true>(F.lds, g, S, E);
        moe_convert_slot(a, F, MQ_B, MQ_C, MQ_LO_C);
    } SEAM(3);
    if (((PHMASK >> 4) & 1) && IN(4)) for (int rep_ = 0; rep_ < ((((unsigned)REP_MASK >> 4) & 1u) ? 2 : 1); ++rep_) { if (rep_) xcd_barrier(bar);
        pg8::Gemm g{(const bf16*)(ws + WS_MIXCAT0), (const bf16*)(ws + WS_WOUT0), NT, 1024, 1024}; pg8::StaticOrder S; S.init(NT, 1024, F.G, bx);
        pg8::EpiPlain E{(bf16*)(ws + WS_MIX), 1024, 4};
        pg8::gemm_phase<pg8::EpiPlain, pg8::StaticOrder, true, true>(F.lds, g, S, E);
    } SEAM(4);
    if (((PHMASK >> 5) & 1) && IN(5)) for (int rep_ = 0; rep_ < ((((unsigned)REP_MASK >> 5) & 1u) ? 2 : 1); ++rep_) { if (rep_) xcd_barrier(bar); resnorm_phase<true, true>(a, F, x, norm_g + 1 * DM); } SEAM(5);

    if (((PHMASK >> 6) & 1) && IN(6)) for (int rep_ = 0; rep_ < ((((unsigned)REP_MASK >> 6) & 1u) ? 2 : 1); ++rep_) { if (rep_) xcd_barrier(bar);
        pg8::Gemm g{(const bf16*)(ws + WS_Z), (const bf16*)(ws + WS_WGU0), NT, 8192, 1024}; pg8::StaticOrder S; S.init(NT, 8192, F.G, bx);
        pg8::EpiSwiGluI8 E{(bf16*)(ws + WS_HFF), 4096, 32, (const float*)(ws + WS_SA), (const float*)(ws + WS_SB)};
        pg8::gemm_phase<pg8::EpiSwiGluI8, pg8::StaticOrder, true, true, 2>(F.lds, g, S, E);
    } SEAM(6);
    if (((PHMASK >> 7) & 1) && IN(7)) for (int rep_ = 0; rep_ < ((((unsigned)REP_MASK >> 7) & 1u) ? 2 : 1); ++rep_) { if (rep_) xcd_barrier(bar);
        pg8::Gemm g{(const bf16*)(ws + WS_HFF), (const bf16*)(ws + WS_WDN0), NT, 1024, 4096}; pg8::StaticOrder S; S.init(NT, 1024, F.G, bx);
        pg8::EpiPlain E{(bf16*)(ws + WS_MIX), 1024, 4};
        pg8::gemm_phase<pg8::EpiPlain, pg8::StaticOrder, true, true>(F.lds, g, S, E);
    } SEAM(7);
    if (((PHMASK >> 8) & 1) && IN(8)) for (int rep_ = 0; rep_ < ((((unsigned)REP_MASK >> 8) & 1u) ? 2 : 1); ++rep_) { if (rep_) xcd_barrier(bar); resnorm_phase<false, true>(a, F, ws + WS_H, norm_g + 3 * DM); } SEAM(8);

    if (((PHMASK >> 9) & 1) && IN(9)) for (int rep_ = 0; rep_ < ((((unsigned)REP_MASK >> 9) & 1u) ? 2 : 1); ++rep_) { if (rep_) xcd_barrier(bar);
        pg8::Gemm g{(const bf16*)(ws + WS_Z), (const bf16*)(ws + WS_WIN1), NT, 1536, 1024}; pg8::StaticOrder S; S.init(NT, 1536, F.G, bx);
        pg8::EpiIn1 E{(bf16*)(ws + WS_HGLU), (bf16*)(ws + WS_CQ), (size_t)(WS_CKV - WS_CQ) / 2, (const float*)(ws + WS_SA), (const float*)(ws + WS_SB1), (float*)(ws + WS_RSS)};
        pg8::gemm_phase<pg8::EpiIn1, pg8::StaticOrder, true, true, 2>(F.lds, g, S, E);
        moe_convert_slot(a, F, MQ_C, MQ_D, MQ_LO_D);
    } SEAM(9);
    if (((PHMASK >> 10) & 1) && IN(10)) for (int rep_ = 0; rep_ < ((((unsigned)REP_MASK >> 10) & 1u) ? 2 : 1); ++rep_) { if (rep_) xcd_barrier(bar);
        { pg8::Gemm g{(const bf16*)(ws + WS_CQ), (const bf16*)(ws + WS_WUQ), NT, 768, 256}; pg8::StaticOrder S; S.init(NT, 768, F.G, bx);
          pg8::EpiQ E{(bf16*)(ws + WS_Q), (const float*)(ws + WS_ROPE), 0.10206207261596577f * 1.4426950408889634f, (const float*)(ws + WS_RSS)};
          PBS(110); pg8::gemm_phase<pg8::EpiQ, pg8::StaticOrder, true, true>(F.lds, g, S, E); PBE(110); }
        { pg8::Gemm g{(const bf16*)(ws + WS_CKV), (const bf16*)(ws + WS_WUKV), NT, 1024, 128, 0, 0, 512};      pg8::StaticOrder S; S.init(NT, 1024, F.G, bx);
          pg8::EpiKV E{(bf16*)(ws + WS_KK), (bf16*)(ws + WS_VV), (const float*)(ws + WS_RSS) + (size_t)NT * 4};
          PBS(111); pg8::gemm_phase<pg8::EpiKV, pg8::StaticOrder, true, true>(F.lds, g, S, E); PBE(111); }
        __syncthreads();
        { PBS(112); conv_prep_phase(a, F); PBE(112); }
        if (F.G == 256 && bx >= 192) moe_convert_range(a, F, MQ_D, MQ_E, (bx - 192) * NWAVES + F.wave, 64 * NWAVES);
    }
    do { PB_B(10); if (IN(11) && IN(12)) xcd_barrier(bar); PB_C(10); PB_A(12); } while (0);
    if (((PHMASK >> 12) & 1) && IN(12)) for (int rep_ = 0; rep_ < ((((unsigned)REP_MASK >> 12) & 1u) ? 2 : 1); ++rep_) { if (rep_) xcd_barrier(bar); attn_phase(a, F); } SEAM(12);
    if (((PHMASK >> 13) & 1) && IN(13)) for (int rep_ = 0; rep_ < ((((unsigned)REP_MASK >> 13) & 1u) ? 2 : 1); ++rep_) { if (rep_) xcd_barrier(bar);
        pg8::Gemm g{(const bf16*)(ws + WS_MIXCAT1), (const bf16*)(ws + WS_WOUT1), NT, 1024, 1024}; pg8::StaticOrder S; S.init(NT, 1024, F.G, bx);
        pg8::EpiPlain E{(bf16*)(ws + WS_MIX), 1024, 4};
        pg8::gemm_phase<pg8::EpiPlain, pg8::StaticOrder, true, true>(F.lds, g, S, E);
    } SEAM(13);
    if (((PHMASK >> 14) & 1) && IN(14)) for (int rep_ = 0; rep_ < ((((unsigned)REP_MASK >> 14) & 1u) ? 2 : 1); ++rep_) { if (rep_) xcd_barrier(bar); resnorm_router_phase(a, F, norm_g + 5 * DM, norm_g + 6 * DM); } SEAM(14);
    if (((PHMASK >> 15) & 1) && IN(15)) for (int rep_ = 0; rep_ < ((((unsigned)REP_MASK >> 15) & 1u) ? 2 : 1); ++rep_) { if (rep_) xcd_barrier(bar); moe_gather_phase(a, F); moe_convert_all(a, F); } SEAM(15);
    if (((PHMASK >> 16) & 1) && IN(16)) for (int rep_ = 0; rep_ < ((((unsigned)REP_MASK >> 16) & 1u) ? 2 : 1); ++rep_) { if (rep_) xcd_barrier(bar);
        pg8::TileOrder S = moe_order(ws, 28, F.G, bx); pg8::Gemm g{(const bf16*)(ws + WS_AG8), (const bf16*)(ws + WS_WGU1), 0, 0, 1024, 0x7F7F7F7F, 0x79797979};
        pg8::EpiSwiGlu8 E{ws + WS_HMOE8, 3584, 28, 8.0f};
        pg8::gemm_phase<pg8::EpiSwiGlu8, pg8::TileOrder, true, true, true>(F.lds, g, S, E);
    } SEAM(16);
    if (((PHMASK >> 17) & 1) && IN(17)) for (int rep_ = 0; rep_ < ((((unsigned)REP_MASK >> 17) & 1u) ? 2 : 1); ++rep_) { if (rep_) xcd_barrier(bar);
        const bool split = F.G == 256;
        { pg8::TileOrder S = moe_order(ws, 4, F.G, bx, split ? pg8::SPLIT_T0 : (1 << 20)); pg8::Gemm g{(const bf16*)(ws + WS_HMOE8), (const bf16*)(ws + WS_WDN1), 0, 0, 3584, 0x7C7C7C7C, 0x78787878};
          pg8::EpiPlain E{(bf16*)(ws + WS_HOUT), 1024, 4};
          pg8::gemm_phase<pg8::EpiPlain, pg8::TileOrder, true, true, true>(F.lds, g, S, E); }
        if (split) { const int* meta = (const int*)(ws + WS_META); const int nl = meta[8] - pg8::SPLIT_T0;
          pg8::SplitOrder S; S.nU = nl > 0 ? nl * 4 * pg8::SPLIT_S : 0; S.nN = 4; S.G = F.G; S.c = bx; S.t0 = pg8::SPLIT_T0;
          S.tp1 = meta[1]; S.tp2 = meta[2]; S.tp3 = meta[3]; S.tp4 = meta[4]; S.tp5 = meta[5]; S.tp6 = meta[6]; S.tp7 = meta[7];
          pg8::Gemm g{(const bf16*)(ws + WS_HMOE8), (const bf16*)(ws + WS_WDN1), 0, 0, pg8::SPLIT_KB, 0x7C7C7C7C, 0x78787878, 3584};
          pg8::EpiPart E{(bf16*)(ws + WS_PART), 4};
          pg8::gemm_phase<pg8::EpiPart, pg8::SplitOrder, true, true, true>(F.lds, g, S, E); }
    } SEAM(17);
    if (PROBE_SEL >= 0) { const unsigned d_ = __hip_atomic_load(&F.ctl[CW_PROBE], __ATOMIC_RELAXED, __HIP_MEMORY_SCOPE_AGENT); const unsigned long long ts_ = wall_clock64();
        while (wall_clock64() - ts_ < (unsigned long long)d_ * PROBE_SCALE) __builtin_amdgcn_s_sleep(8); }
    if (((PHMASK >> 18) & 1) && IN(18)) for (int rep_ = 0; rep_ < ((((unsigned)REP_MASK >> 18) & 1u) ? 2 : 1); ++rep_) { if (rep_) xcd_barrier(bar); moe_combine_phase(a, F, norm_g + 7 * DM, F.G == 256 ? pg8::SPLIT_T0 * 256 : (1 << 30)); }

    if (IN(99)) {
        const f32x4* src = (const f32x4*)x; f32x4* dst = (f32x4*)a.out;
        for (size_t i = (size_t)bx * NTHR + F.tid; i < (size_t)NT * DM / 4; i += (size_t)F.G * NTHR) dst[i] = src[i];
    }
#undef IN
#undef SEAM
#undef PB_A
#undef PB_B
#undef PB_C
}

static void fill_desc(TDesc& d, const float* W, bf16* WT, const float* gain, int ldw, int K, int N, int Kd, int map, int roff, int nb, long sstride, long dstride, int& item0, float scale = 1.0f, int fp8 = 0) {
    d.W = W; d.WT = WT; d.gain = gain; d.sstride = sstride; d.dstride = dstride; d.ldw = ldw; d.K = K; d.N = N; d.Kd = Kd; d.map = map; d.roff = roff; d.nb = nb; d.item0 = item0; d.scale = scale; d.fp8 = fp8;
    if (fp8 != 2) item0 += nb * (K / 64) * (N / 32);
}
extern "C" void kernel_launch(void* const* d_in, const int* in_sizes, int n_in, void* d_out, int out_size, void* d_ws, size_t ws_size, hipStream_t stream) {
    static int grid = 0;
    if (grid == 0) {
        if (n_in != 34 || out_size != NT * DM || ws_size < WS_END) { fprintf(stderr, "kernel_launch: unexpected shapes (n_in %d, out %d, ws %zu < %zu)\n", n_in, out_size, ws_size, (size_t)WS_END); grid = -1; return; }
        int dev = 0, cus = 0, per_cu = 0;
        if (hipGetDevice(&dev) != hipSuccess || hipDeviceGetAttribute(&cus, hipDeviceAttributeMultiprocessorCount, dev) != hipSuccess) { grid = -1; return; }
        if (hipFuncSetAttribute((const void*)fwd, hipFuncAttributeMaxDynamicSharedMemorySize, LDS_BYTES) != hipSuccess) { fprintf(stderr, "kernel_launch: hipFuncSetAttribute failed\n"); grid = -1; return; }
        if (hipOccupancyMaxActiveBlocksPerMultiprocessor(&per_cu, (const void*)fwd, NTHR, LDS_BYTES) != hipSuccess || per_cu < 1) { fprintf(stderr, "kernel_launch: occupancy query says %d\n", per_cu); }
        (void)hipGetLastError();
        grid = cus;
    }
    if (grid < 0) return;
    unsigned char* ws = (unsigned char*)d_ws;
    (void)hipMemsetAsync(ws + WS_CTL, 0, CTL_ZERO_BYTES, stream);
    Args a{};
    for (int i = 0; i < 34; ++i) a.in[i] = (const float*)d_in[i];
    a.out = (float*)d_out; a.ws = ws;
    const float* ng = a.in[1]; int it0 = 0;
    fill_desc(a.td[0], a.in[2], (bf16*)(ws + WS_WIN0), ng + 0 * DM, 1536, 1024, 1536, 1024, 0, 0, 1, 0, 0, it0, 1.0f, 2);
    fill_desc(a.td[1], a.in[11], (bf16*)(ws + WS_WGLU), nullptr, 512, 512, 512, 512, 0, 0, 1, 0, 0, it0);
    fill_desc(a.td[2], a.in[16], (bf16*)(ws + WS_WOUT0), nullptr, 1024, 1024, 1024, 1024, 0, 0, 1, 0, 0, it0);
    fill_desc(a.td[3], a.in[17], (bf16*)(ws + WS_WGU0), ng + 2 * DM, 4096, 1024, 4096, 1024, 1, 0, 1, 0, 0, it0, 1.0f, 2);
    fill_desc(a.td[4], a.in[18], (bf16*)(ws + WS_WGU0), ng + 2 * DM, 4096, 1024, 4096, 1024, 2, 0, 1, 0, 0, it0, 1.0f, 2);
    fill_desc(a.td[5], a.in[19], (bf16*)(ws + WS_WDN0), nullptr, 1024, 4096, 1024, 4096, 0, 0, 1, 0, 0, it0);
    fill_desc(a.td[6], a.in[20], (bf16*)(ws + WS_WIN1), ng + 4 * DM, 1440, 1024, 512, 1024, 1, 0, 1, 0, 0, it0, 1.0f, 2);
    fill_desc(a.td[7], a.in[20] + 512, (bf16*)(ws + WS_WIN1), ng + 4 * DM, 1440, 1024, 512, 1024, 2, 0, 1, 0, 0, it0, 1.0f, 2);
    fill_desc(a.td[8], a.in[20] + 1024, (bf16*)(ws + WS_WIN1), ng + 4 * DM, 1440, 1024, 416, 1024, 0, 1024, 1, 0, 0, it0, 1.0f, 2);
    fill_desc(a.td[9], a.in[26], (bf16*)(ws + WS_WUQ), a.in[25], 768, 256, 768, 256, 0, 0, 1, 0, 0, it0);
    fill_desc(a.td[10], a.in[28], (bf16*)(ws + WS_WUKV), a.in[27], 1024, 128, 1024, 256, 0, 0, 1, 0, 0, it0);
    fill_desc(a.td[11], a.in[29], (bf16*)(ws + WS_WOUT1), nullptr, 1024, 1024, 1024, 1024, 0, 0, 1, 0, 0, it0);
    fill_desc(a.td[12], a.in[31], (bf16*)(ws + WS_WGU1), ng + 6 * DM, 3584, 1024, 3584, 1024, 1, 0, 8, (long)1024 * 3584, (long)7168 * 1024, it0, 64.0f, 1);
    fill_desc(a.td[13], a.in[32], (bf16*)(ws + WS_WGU1), ng + 6 * DM, 3584, 1024, 3584, 1024, 2, 0, 8, (long)1024 * 3584, (long)7168 * 1024, it0, 64.0f, 1);
    fill_desc(a.td[14], a.in[33], (bf16*)(ws + WS_WDN1), nullptr, 1024, 3584, 1024, 3584, 0, 0, 8, (long)3584 * 1024, (long)1024 * 3584, it0, 128.0f, 1);
    a.n_items = it0;
    const int last = DBG_STOP;
#if ONE_LAUNCH
    a.ph_lo = 0; a.ph_hi = last + 1; a.dbg = 0;
    hipLaunchKernelGGL(fwd, dim3(grid), dim3(NTHR), LDS_BYTES, stream, a);
#else
    for (int p = 0; p <= last; ++p) { a.ph_lo = p; a.ph_hi = p + 1; a.dbg = 0; hipLaunchKernelGGL(fwd, dim3(grid), dim3(NTHR), LDS_BYTES, stream, a); }
#endif
    if (last < NPHASE - 1) { a.ph_lo = 99; a.ph_hi = 100; a.dbg = 1; hipLaunchKernelGGL(fwd, dim3(grid), dim3(NTHR), LDS_BYTES, stream, a); }
}
```
